# Optimizing an MI355X kernel written in HIP

```python
import jax
import jax.numpy as jnp
from jax import lax
import numpy as np

D_MODEL = 1024
BATCH = 2
SEQ = 16384
DEPTH = 4

FOX_HEADS = 8
FOX_HEAD_DIM = 64
MLA_HEADS = 8
MLA_Q_RANK = 256
MLA_KV_RANK = 128
MLA_NOPE_DIM = 64
MLA_ROPE_DIM = 32
MLA_V_DIM = 64
ROPE_THETA = 10000.0
DN_HEADS = 8
DN_HEAD_DIM = 64
DN_CONV_WIDTH = 4
DN_CHUNK = 64
D_FF = 2816
Q_BLOCK = 128
N_BRANCH = 3
NORM_EPS = 1e-6

FOX_WIDTH = FOX_HEADS * FOX_HEAD_DIM
MLA_QK_DIM = MLA_NOPE_DIM + MLA_ROPE_DIM
MLA_WIDTH = MLA_HEADS * MLA_V_DIM
DN_WIDTH = DN_HEADS * DN_HEAD_DIM
IN_WIDTHS = (FOX_WIDTH, FOX_WIDTH, FOX_WIDTH, FOX_HEADS,
             MLA_Q_RANK, MLA_KV_RANK, MLA_ROPE_DIM,
             DN_WIDTH, DN_WIDTH, DN_WIDTH, DN_WIDTH, DN_HEADS, DN_HEADS,
             N_BRANCH * D_MODEL)
N_IN = sum(IN_WIDTHS)

kernel_name = 'hybrid_fox_mla_gdn_macaron'


def rmsnorm(x, gain):
    xf = x.astype(jnp.float32)
    y = xf * lax.rsqrt(jnp.mean(xf * xf, axis=-1, keepdims=True) + NORM_EPS)
    return (y * gain.astype(jnp.float32)).astype(x.dtype)


def l2norm(x):
    xf = x.astype(jnp.float32)
    return xf * lax.rsqrt(jnp.sum(xf * xf, axis=-1, keepdims=True) + NORM_EPS)


def swiglu(h, w_gu, w_down):
    gate, up = jnp.split(h @ w_gu, 2, axis=-1)
    return (jax.nn.silu(gate) * up) @ w_down


def rope_tables(positions):
    half = MLA_ROPE_DIM // 2
    inv_freq = ROPE_THETA ** (-jnp.arange(half, dtype=jnp.float32) / half)
    ang = positions.astype(jnp.float32)[..., None] * inv_freq
    return jnp.cos(ang)[:, :, None, :], jnp.sin(ang)[:, :, None, :]


def apply_rope(x, cos, sin):
    x1, x2 = jnp.split(x.astype(jnp.float32), 2, axis=-1)
    return jnp.concatenate([x1 * cos - x2 * sin, x2 * cos + x1 * sin], axis=-1).astype(x.dtype)


def causal_short_conv(x, w):
    width = w.shape[0]
    s = x.shape[1]
    xp = jnp.pad(x, ((0, 0), (width - 1, 0), (0, 0)))
    return sum(xp[:, i:i + s] * w[i] for i in range(width))


def block_causal_attention(q, k, v, scale, log_decay_cum=None):
    b, s, h, dqk = q.shape
    dv = v.shape[-1]
    nb = s // Q_BLOCK
    q_blocks = q.reshape(b, nb, Q_BLOCK, h, dqk).transpose(1, 0, 3, 2, 4)
    k_pos = jnp.arange(s)
    xs = (jnp.arange(nb), q_blocks)
    if log_decay_cum is not None:
        c = log_decay_cum.astype(jnp.float32).transpose(0, 2, 1)
        c_blocks = c.reshape(b, h, nb, Q_BLOCK).transpose(2, 0, 1, 3)
        xs = (jnp.arange(nb), q_blocks, c_blocks)

    def one_block(args):
        idx, q_blk = args[0], args[1]
        logits = jnp.einsum('bhqd,bkhd->bhqk', q_blk, k).astype(jnp.float32) * scale
        if log_decay_cum is not None:
            logits = logits + args[2][..., :, None] - c[:, :, None, :]
        q_pos = idx * Q_BLOCK + jnp.arange(Q_BLOCK)
        logits = jnp.where(k_pos[None, :] <= q_pos[:, None], logits, -jnp.inf)
        p = jax.nn.softmax(logits, axis=-1).astype(v.dtype)
        return jnp.einsum('bhqk,bkhd->bqhd', p, v)

    out = lax.map(one_block, xs)
    return out.transpose(1, 0, 2, 3, 4).reshape(b, s, h, dv)


def chunk_gated_delta_rule(q, k, v, g, beta):
    b, s, h, dk = q.shape
    dv = v.shape[-1]
    nc = s // DN_CHUNK

    def to_chunks(t):
        return jnp.moveaxis(t.reshape((b, nc, DN_CHUNK, h) + t.shape[3:]), 3, 2)

    q, k, v, g, beta = (to_chunks(t) for t in (q, k, v, g, beta))
    gc = jnp.cumsum(g, axis=-1)
    idx = jnp.arange(DN_CHUNK)
    causal = idx[:, None] >= idx[None, :]
    strict = idx[:, None] > idx[None, :]
    decay_mat = jnp.exp(jnp.where(causal, gc[..., :, None] - gc[..., None, :], -jnp.inf))
    k_beta = k * beta[..., None]
    v_beta = v * beta[..., None]
    m = jnp.where(strict, jnp.einsum('bnhid,bnhjd->bnhij', k_beta, k) * decay_mat, 0.0)
    eye = jnp.eye(DN_CHUNK, dtype=jnp.float32)
    t_inv = lax.linalg.triangular_solve(eye + m, jnp.broadcast_to(eye, m.shape),
                                        left_side=True, lower=True, unit_diagonal=True)
    w = t_inv @ (k_beta * jnp.exp(gc)[..., None])
    u = t_inv @ v_beta
    qk = jnp.einsum('bnhid,bnhjd->bnhij', q, k) * decay_mat
    q_dec = q * jnp.exp(gc)[..., None]
    k_dec = k * jnp.exp(gc[..., -1:] - gc)[..., None]
    g_last = jnp.exp(gc[..., -1])

    def step(state, xs_c):
        w_c, u_c, qk_c, q_c, k_c, gl = xs_c
        v_new = u_c - w_c @ state
        o_c = q_c @ state + qk_c @ v_new
        state = state * gl[..., None, None] + jnp.einsum('bhcd,bhce->bhde', k_c, v_new)
        return state, o_c

    xs = tuple(jnp.moveaxis(t, 1, 0) for t in (w, u, qk, q_dec, k_dec, g_last))
    state0 = jnp.zeros((b, h, dk, dv), jnp.float32)
    _, o = lax.scan(step, state0, xs)
    return o.transpose(1, 0, 3, 2, 4).reshape(b, s, h, dv)


def hybrid_mixer(h, cos, sin, w_in, b_gate, fox_b_f, mla_q_norm, mla_w_uq, mla_kv_norm, mla_w_ukv,
                 dn_conv_w, dn_a_log, dn_dt_bias, dn_o_norm, w_br_fox, w_br_mla, w_br_dn, w_out):
    b, s, _ = h.shape
    f32 = jnp.float32
    splits = np.cumsum(IN_WIDTHS)[:-1]
    (fox_q, fox_k, fox_v, fox_f, mla_cq, mla_ckv, mla_kr,
     dn_q, dn_k, dn_v, dn_z, dn_b, dn_a, gate_logits) = jnp.split(h @ w_in, splits, axis=-1)

    fox_shape = (b, s, FOX_HEADS, FOX_HEAD_DIM)
    log_f = jax.nn.log_sigmoid(fox_f.astype(f32) + fox_b_f.astype(f32))
    fox_out = block_causal_attention(fox_q.reshape(fox_shape), fox_k.reshape(fox_shape),
                                     fox_v.reshape(fox_shape), FOX_HEAD_DIM ** -0.5,
                                     jnp.cumsum(log_f, axis=1))
    y_fox = fox_out.reshape(b, s, FOX_WIDTH) @ w_br_fox

    q = (rmsnorm(mla_cq, mla_q_norm) @ mla_w_uq).reshape(b, s, MLA_HEADS, MLA_QK_DIM)
    q_nope, q_rope = jnp.split(q, [MLA_NOPE_DIM], axis=-1)
    kv = (rmsnorm(mla_ckv, mla_kv_norm) @ mla_w_ukv).reshape(b, s, MLA_HEADS, MLA_NOPE_DIM + MLA_V_DIM)
    k_nope, mla_v = jnp.split(kv, [MLA_NOPE_DIM], axis=-1)
    k_rope = apply_rope(mla_kr[:, :, None, :], cos, sin)
    q_full = jnp.concatenate([q_nope, apply_rope(q_rope, cos, sin)], axis=-1)
    k_full = jnp.concatenate([k_nope, jnp.broadcast_to(k_rope, (b, s, MLA_HEADS, MLA_ROPE_DIM))], axis=-1)
    mla_out = block_causal_attention(q_full, k_full, mla_v, MLA_QK_DIM ** -0.5)
    y_mla = mla_out.reshape(b, s, MLA_WIDTH) @ w_br_mla

    qkv = jax.nn.silu(causal_short_conv(jnp.concatenate([dn_q, dn_k, dn_v], axis=-1), dn_conv_w))
    cq, ck, cv = jnp.split(qkv, 3, axis=-1)
    dn_shape = (b, s, DN_HEADS, DN_HEAD_DIM)
    q_dn = l2norm(cq.reshape(dn_shape)) * (DN_HEAD_DIM ** -0.5)
    k_dn = l2norm(ck.reshape(dn_shape))
    v_dn = cv.reshape(dn_shape).astype(f32)
    beta = jax.nn.sigmoid(dn_b.astype(f32))
    g = -jnp.exp(dn_a_log.astype(f32)) * jax.nn.softplus(dn_a.astype(f32) + dn_dt_bias.astype(f32))
    o = chunk_gated_delta_rule(q_dn, k_dn, v_dn, g, beta)
    o = rmsnorm(o, dn_o_norm).astype(h.dtype) * jax.nn.silu(dn_z.reshape(dn_shape))
    y_dn = o.reshape(b, s, DN_WIDTH) @ w_br_dn

    g_fox, g_mla, g_dn = jnp.split(jax.nn.sigmoid(gate_logits + b_gate), N_BRANCH, axis=-1)
    return (g_fox * y_fox + g_mla * y_mla + g_dn * y_dn) @ w_out


def setup_inputs(seed: int = 0) -> dict:
    key = jax.random.key(seed)
    ks = iter(list(jax.random.split(key, 32)))
    f32 = jnp.float32
    L = DEPTH

    def nrm(shape, scale):
        return jax.random.normal(next(ks), shape, f32) * scale

    def gain(shape):
        return 1.0 + nrm(shape, 0.1)

    x = jax.random.normal(next(ks), (BATCH, SEQ, D_MODEL), f32)
    positions = (jnp.arange(SEQ, dtype=jnp.int32)[None, :]
                 + jax.random.randint(next(ks), (BATCH, 1), 0, 1024, dtype=jnp.int32))
    ffn1_norm = gain((L, D_MODEL))
    ffn1_w_gu = nrm((L, D_MODEL, 2 * D_FF), D_MODEL ** -0.5)
    ffn1_w_down = nrm((L, D_FF, D_MODEL), D_FF ** -0.5)
    mix_norm = gain((L, D_MODEL))
    w_in = nrm((L, D_MODEL, N_IN), D_MODEL ** -0.5)
    b_gate = nrm((L, N_BRANCH * D_MODEL), 0.1)
    fox_b_f = 4.0 + nrm((L, FOX_HEADS), 0.5)
    mla_q_norm = gain((L, MLA_Q_RANK))
    mla_w_uq = nrm((L, MLA_Q_RANK, MLA_HEADS * MLA_QK_DIM), MLA_Q_RANK ** -0.5)
    mla_kv_norm = gain((L, MLA_KV_RANK))
    mla_w_ukv = nrm((L, MLA_KV_RANK, MLA_HEADS * (MLA_NOPE_DIM + MLA_V_DIM)), MLA_KV_RANK ** -0.5)
    dn_conv_w = nrm((L, DN_CONV_WIDTH, 3 * DN_WIDTH), DN_CONV_WIDTH ** -0.5)
    dn_a_log = jnp.log(jax.random.uniform(next(ks), (L, DN_HEADS), f32, 1.0, 16.0))
    dt = jnp.exp(jax.random.uniform(next(ks), (L, DN_HEADS), f32,
                                    float(np.log(1e-3)), float(np.log(1e-1))))
    dn_dt_bias = dt + jnp.log(-jnp.expm1(-dt))
    dn_o_norm = gain((L, DN_HEAD_DIM))
    w_br_fox = nrm((L, FOX_WIDTH, D_MODEL), FOX_WIDTH ** -0.5)
    w_br_mla = nrm((L, MLA_WIDTH, D_MODEL), MLA_WIDTH ** -0.5)
    w_br_dn = nrm((L, DN_WIDTH, D_MODEL), DN_WIDTH ** -0.5)
    w_out = nrm((L, D_MODEL, D_MODEL), D_MODEL ** -0.5)
    ffn2_norm = gain((L, D_MODEL))
    ffn2_w_gu = nrm((L, D_MODEL, 2 * D_FF), D_MODEL ** -0.5)
    ffn2_w_down = nrm((L, D_FF, D_MODEL), D_FF ** -0.5)
    final_norm = gain((D_MODEL,))
    return {'x': x, 'positions': positions,
            'ffn1_norm': ffn1_norm, 'ffn1_w_gu': ffn1_w_gu, 'ffn1_w_down': ffn1_w_down,
            'mix_norm': mix_norm, 'w_in': w_in, 'b_gate': b_gate, 'fox_b_f': fox_b_f,
            'mla_q_norm': mla_q_norm, 'mla_w_uq': mla_w_uq, 'mla_kv_norm': mla_kv_norm, 'mla_w_ukv': mla_w_ukv,
            'dn_conv_w': dn_conv_w, 'dn_a_log': dn_a_log, 'dn_dt_bias': dn_dt_bias, 'dn_o_norm': dn_o_norm,
            'w_br_fox': w_br_fox, 'w_br_mla': w_br_mla, 'w_br_dn': w_br_dn, 'w_out': w_out,
            'ffn2_norm': ffn2_norm, 'ffn2_w_gu': ffn2_w_gu, 'ffn2_w_down': ffn2_w_down,
            'final_norm': final_norm}


def reference(x, positions, ffn1_norm, ffn1_w_gu, ffn1_w_down, mix_norm, w_in, b_gate, fox_b_f,
              mla_q_norm, mla_w_uq, mla_kv_norm, mla_w_ukv, dn_conv_w, dn_a_log, dn_dt_bias, dn_o_norm,
              w_br_fox, w_br_mla, w_br_dn, w_out, ffn2_norm, ffn2_w_gu, ffn2_w_down, final_norm):
    cos, sin = rope_tables(positions)
    for l in range(DEPTH):
        x = x + 0.5 * swiglu(rmsnorm(x, ffn1_norm[l]), ffn1_w_gu[l], ffn1_w_down[l])
        x = x + hybrid_mixer(rmsnorm(x, mix_norm[l]), cos, sin, w_in[l], b_gate[l], fox_b_f[l],
                             mla_q_norm[l], mla_w_uq[l], mla_kv_norm[l], mla_w_ukv[l],
                             dn_conv_w[l], dn_a_log[l], dn_dt_bias[l], dn_o_norm[l],
                             w_br_fox[l], w_br_mla[l], w_br_dn[l], w_out[l])
        x = x + 0.5 * swiglu(rmsnorm(x, ffn2_norm[l]), ffn2_w_gu[l], ffn2_w_down[l])
    return rmsnorm(x, final_norm)
```

```cpp
#include <hip/hip_runtime.h>
#include <hip/hip_cooperative_groups.h>
#include <stdint.h>
#include <cstdio>
#include <type_traits>
namespace cg = cooperative_groups;

#ifndef PROBE_DUP
#define PROBE_DUP 0
#endif
#ifndef ONE_LAUNCH
#define ONE_LAUNCH 1
#endif

typedef unsigned short bf16_t;
typedef short bf16x8 __attribute__((ext_vector_type(8)));
typedef float f32x16 __attribute__((ext_vector_type(16)));
typedef float f32x4 __attribute__((ext_vector_type(4)));
typedef unsigned int u32x4 __attribute__((ext_vector_type(4)));
typedef unsigned int u32x2 __attribute__((ext_vector_type(2)));
typedef float f32x2 __attribute__((ext_vector_type(2)));

constexpr int TOK = 32768, TH = 16384, DM = 1024, DFF = 2816, NLAYER = 4, NIN = 7096;
constexpr int PBW = 3968;
constexpr int PB_CQ = 1536, PB_CKV = 1792, PB_DN = 1920;
constexpr float EPS = 1e-6f;
constexpr float LOG2E = 1.4426950408889634f;
constexpr int LDS_BYTES = 77824;
constexpr int NPHASE = 2 + 21 * NLAYER;

constexpr size_t OFF_CTRL = 0;
constexpr size_t OFF_ROPE = 32768;
constexpr size_t OFF_WB   = OFF_ROPE + (size_t)TOK * 32 * 4;
constexpr size_t W_GU1 = 0;
constexpr size_t W_DN1 = W_GU1 + (size_t)5632 * 1024;
constexpr size_t W_IN  = W_DN1 + (size_t)1024 * 2816;
constexpr size_t W_G   = W_IN + (size_t)4096 * 1024;
constexpr size_t W_UQ  = W_G + (size_t)3072 * 1024;
constexpr size_t W_UKV = W_UQ + (size_t)768 * 256;
constexpr size_t W_BRF = W_UKV + (size_t)1024 * 128;
constexpr size_t W_BRM = W_BRF + (size_t)1024 * 512;
constexpr size_t W_BRD = W_BRM + (size_t)1024 * 512;
constexpr size_t W_OUT = W_BRD + (size_t)1024 * 512;
constexpr size_t W_GU2 = W_OUT + (size_t)1024 * 1024;
constexpr size_t W_DN2 = W_GU2 + (size_t)5632 * 1024;
constexpr size_t W_END = W_DN2 + (size_t)1024 * 2816;
constexpr size_t OFF_HB  = OFF_WB + W_END * 2;
constexpr size_t OFF_BIG = OFF_HB + (size_t)TOK * DM * 2;
constexpr size_t OFF_PB  = OFF_BIG;
constexpr size_t OFF_S32 = OFF_PB + (size_t)TH * PBW * 2;
constexpr size_t OFF_VTF = OFF_S32 + (size_t)TH * 64 * 4;
constexpr size_t OFF_QF  = OFF_VTF + (size_t)512 * TH * 2;
constexpr size_t OFF_KM  = OFF_QF + (size_t)TH * 768 * 2;
constexpr size_t OFF_VTM = OFF_KM + (size_t)TH * 768 * 2;
constexpr size_t OFF_CF  = OFF_VTM + (size_t)512 * TH * 2;
constexpr size_t OFF_RQ  = OFF_CF + (size_t)8 * TH * 4;
constexpr size_t OFF_RKV = OFF_RQ + (size_t)TH * 4;
constexpr size_t OFF_DNA = OFF_RKV + (size_t)TH * 4;
constexpr size_t DN_SZ   = (size_t)2048 * 4096 * 4;
constexpr size_t OFF_DNB = OFF_DNA + DN_SZ;
constexpr size_t OFF_DNS = OFF_DNB + DN_SZ;
constexpr size_t OFF_DNQ = OFF_DNS + DN_SZ;
constexpr size_t OFF_DNO = OFF_DNQ + DN_SZ;
constexpr size_t OFF_MIX = OFF_DNA;
constexpr size_t OFF_G   = OFF_DNB;
constexpr size_t WS_END  = OFF_DNO + DN_SZ;
static_assert(WS_END >= OFF_BIG + (size_t)TOK * DFF * 2, "act fits");

struct Params {
    const float* x; const int* pos;
    const float *ffn1_norm, *ffn1_gu, *ffn1_down, *mix_norm, *w_in, *b_gate, *fox_bf, *mla_qn, *mla_uq, *mla_kvn, *mla_ukv,
        *dn_conv, *dn_alog, *dn_dtb, *dn_onorm, *br_fox, *br_mla, *br_dn, *w_out, *ffn2_norm, *ffn2_gu, *ffn2_down, *final_norm;
    float* out; unsigned char* ws;
};

__device__ __forceinline__ int tidx() { int t = threadIdx.x; asm volatile("" : "+v"(t)); return t; }
__device__ __forceinline__ void lds_barrier() { asm volatile("s_waitcnt lgkmcnt(0)\n\ts_barrier" ::: "memory"); }
#define XB_TMO      128
#define XB_XCNT(j)  (256  + 64 * (j))
#define XB_XSUB(j)  (1280 + 64 * (j))
#define XB_XGEN(j)  (2304 + 64 * (j))
#define XB_TOP      3328
#define XB_TOPGEN   3392
#define XCD_BAR_WORDS 3456
#define XB_SPIN_CAP (1u << 22)
#define LAS __attribute__((address_space(3)))
__device__ __forceinline__ unsigned xb_ld(unsigned* p)              { return __hip_atomic_load(p, __ATOMIC_RELAXED, __HIP_MEMORY_SCOPE_AGENT); }
__device__ __forceinline__ unsigned xb_add(unsigned* p, unsigned v) { return __hip_atomic_fetch_add(p, v, __ATOMIC_RELAXED, __HIP_MEMORY_SCOPE_AGENT); }
__device__ __forceinline__ unsigned xb_xcc_id() { return (unsigned)__builtin_amdgcn_s_getreg((3 << 11) | 20) & 0xFu; }
#define XB_SPIN(cond, bar) do { unsigned _sp = 0; while (cond) { __builtin_amdgcn_s_sleep(1); \
    if ((++_sp & 255u) == 0u) { if (xb_ld(&(bar)[XB_TMO])) break; if (_sp > XB_SPIN_CAP) { atomicAdd(&(bar)[XB_TMO], 1u); break; } } } } while (0)
struct XcdBarrier { unsigned* bar; unsigned x; volatile LAS unsigned* st; };
__device__ __forceinline__ XcdBarrier xcd_barrier_post(unsigned* bar, volatile LAS unsigned* st) {
    XcdBarrier b; b.bar = bar; b.x = xb_xcc_id(); b.st = st;
    if (threadIdx.x == 0) (void)xb_add(&bar[XB_XCNT(b.x)], 1u);
    return b;
}
__device__ __forceinline__ void xcd_barrier_complete(unsigned* bar, unsigned x, unsigned& nloc, unsigned& nx) {
    const unsigned G = gridDim.x * gridDim.y * gridDim.z;
    unsigned sum, cnt, mine, sp = 0u;
    for (;;) {
        sum = 0u; cnt = 0u; mine = 0u;
#pragma unroll
        for (unsigned j = 0; j < 16; ++j) { const unsigned c = xb_ld(&bar[XB_XCNT(j)]); sum += c; cnt += (c > 0u) ? 1u : 0u; mine = (j == x) ? c : mine; }
        if (sum == G) break;
        __builtin_amdgcn_s_sleep(1);
        if ((++sp & 255u) == 0u) { if (xb_ld(&bar[XB_TMO])) break; if (sp > XB_SPIN_CAP) { atomicAdd(&bar[XB_TMO], 1u); break; } }
    }
    nloc = mine > 0u ? mine : 1u; nx = cnt > 0u ? cnt : 1u;
}
__device__ __forceinline__ void xcd_barrier(const XcdBarrier& b) {
    asm volatile("s_waitcnt vmcnt(0)" ::: "memory");
    __syncthreads();
    if (threadIdx.x == 0) {
        unsigned* bar = b.bar;
        __builtin_amdgcn_s_waitcnt(0);
        unsigned nloc = b.st[0], nx = b.st[1];
        if (nloc == 0u) { xcd_barrier_complete(bar, b.x, nloc, nx); b.st[0] = nloc; b.st[1] = nx; }
        const unsigned old = xb_add(&bar[XB_XSUB(b.x)], 1u);
        const unsigned gen = old / nloc;
        if (old + 1u == (gen + 1u) * nloc) {
            __builtin_amdgcn_fence(__ATOMIC_RELEASE, "agent");
            asm volatile("s_waitcnt vmcnt(0)" ::: "memory");
            const unsigned og = xb_add(&bar[XB_TOP], 1u);
            const unsigned tg = og / nx;
            if (og + 1u == (tg + 1u) * nx) xb_add(&bar[XB_TOPGEN], 1u);
            else XB_SPIN(xb_ld(&bar[XB_TOPGEN]) == tg, bar);
            __builtin_amdgcn_fence(__ATOMIC_ACQUIRE, "agent");
            xb_add(&bar[XB_XGEN(b.x)], 1u);
            asm volatile("s_waitcnt vmcnt(0)" ::: "memory");
        } else {
            XB_SPIN(xb_ld(&bar[XB_XGEN(b.x)]) == gen, bar);
            __builtin_amdgcn_fence(__ATOMIC_ACQUIRE, "agent");
            asm volatile("s_waitcnt vmcnt(0)" ::: "memory");
        }
    }
    __syncthreads();
}
typedef __bf16 bf16x2_t __attribute__((ext_vector_type(2)));
__device__ __forceinline__ uint32_t pk2(float lo, float hi) { typedef float f2 __attribute__((ext_vector_type(2))); const f2 v = {lo, hi}; return __builtin_bit_cast(uint32_t, __builtin_convertvector(v, bf16x2_t)); }
__device__ __forceinline__ float bflo(uint32_t u) { return __uint_as_float(u << 16); }
__device__ __forceinline__ float bfhi(uint32_t u) { return __uint_as_float(u & 0xffff0000u); }
__device__ __forceinline__ float max3f(float a, float b, float c) { float r; asm("v_max3_f32 %0, %1, %2, %3" : "=v"(r) : "v"(a), "v"(b), "v"(c)); return r; }
__device__ __forceinline__ void halves32(float x, float& lo_half, float& hi_half) {
    typedef unsigned int u2v __attribute__((ext_vector_type(2)));
    const u2v rr = __builtin_amdgcn_permlane32_swap(__builtin_bit_cast(unsigned, x), __builtin_bit_cast(unsigned, x), false, false);
    lo_half = __builtin_bit_cast(float, rr.x); hi_half = __builtin_bit_cast(float, rr.y);
}
__device__ __forceinline__ float ex2(float x) { return __builtin_amdgcn_exp2f(x); }
__device__ __forceinline__ float siluf(float x) { return x * __builtin_amdgcn_rcpf(1.f + __expf(-x)); }
__device__ __forceinline__ float sigmf(float x) { return __builtin_amdgcn_rcpf(1.f + __expf(-x)); }
__device__ __forceinline__ float wave_sum(float v) {
#pragma unroll
    for (int o = 1; o < 64; o <<= 1) v += __shfl_xor(v, o);
    return v;
}
__device__ __forceinline__ f32x16 mfma32(bf16x8 a, bf16x8 b, f32x16 c) { return __builtin_amdgcn_mfma_f32_32x32x16_bf16(a, b, c, 0, 0, 0); }
__device__ __forceinline__ f32x4 mfma16(bf16x8 a, bf16x8 b, f32x4 c) { return __builtin_amdgcn_mfma_f32_16x16x32_bf16(a, b, c, 0, 0, 0); }
__device__ __forceinline__ bf16x8 mk8(uint32_t a, uint32_t b, uint32_t c, uint32_t d) { u32x4 v = {a, b, c, d}; return __builtin_bit_cast(bf16x8, v); }

struct WDesc { const float* W; int ldw, K, Np, kind; bf16_t* Bt; const float* kgain; };
__device__ __forceinline__ int srccol(int kind, int n) {
    if (kind == 0) return n;
    if (kind == 1) { return 64 * (n >> 7) + 32 * ((n >> 6) & 1) + (n & 31) + ((n >> 5) & 1) * DFF; }
    if (kind == 3) return 4024 + n;
    if (n < 1536) return n;
    if (n < 1792) return 1544 + (n - 1536);
    if (n < 1920) return 1800 + (n - 1792);
    if (n < 3968) return 1960 + (n - 1920);
    int j = n - 3968;
    if (j < 8) return 1536 + j;
    if (j < 16) return 4008 + (j - 8);
    if (j < 24) return 4016 + (j - 16);
    if (j >= 32 && j < 64) return 1928 + (j - 32);
    return -1;
}
__device__ __forceinline__ WDesc wdesc(const Params& p, int l, int m) {
    bf16_t* wb = (bf16_t*)(p.ws + OFF_WB);
    WDesc d; d.kgain = nullptr; d.kind = 0;
    switch (m) {
    case 0: d.W = p.ffn1_gu + (size_t)l * 1024 * 5632; d.ldw = 5632; d.K = 1024; d.Np = 5632; d.kind = 1; d.Bt = wb + W_GU1; break;
    case 1: d.W = p.ffn1_down + (size_t)l * 2816 * 1024; d.ldw = 1024; d.K = 2816; d.Np = 1024; d.Bt = wb + W_DN1; break;
    case 2: d.W = p.w_in + (size_t)l * 1024 * NIN; d.ldw = NIN; d.K = 1024; d.Np = 4096; d.kind = 2; d.Bt = wb + W_IN; break;
    case 3: d.W = p.w_in + (size_t)l * 1024 * NIN; d.ldw = NIN; d.K = 1024; d.Np = 3072; d.kind = 3; d.Bt = wb + W_G; break;
    case 4: d.W = p.mla_uq + (size_t)l * 256 * 768; d.ldw = 768; d.K = 256; d.Np = 768; d.Bt = wb + W_UQ; d.kgain = p.mla_qn + l * 256; break;
    case 5: d.W = p.mla_ukv + (size_t)l * 128 * 1024; d.ldw = 1024; d.K = 128; d.Np = 1024; d.Bt = wb + W_UKV; d.kgain = p.mla_kvn + l * 128; break;
    case 6: d.W = p.br_fox + (size_t)l * 512 * 1024; d.ldw = 1024; d.K = 512; d.Np = 1024; d.Bt = wb + W_BRF; break;
    case 7: d.W = p.br_mla + (size_t)l * 512 * 1024; d.ldw = 1024; d.K = 512; d.Np = 1024; d.Bt = wb + W_BRM; break;
    case 8: d.W = p.br_dn + (size_t)l * 512 * 1024; d.ldw = 1024; d.K = 512; d.Np = 1024; d.Bt = wb + W_BRD; break;
    case 9: d.W = p.w_out + (size_t)l * 1024 * 1024; d.ldw = 1024; d.K = 1024; d.Np = 1024; d.Bt = wb + W_OUT; break;
    case 10: d.W = p.ffn2_gu + (size_t)l * 1024 * 5632; d.ldw = 5632; d.K = 1024; d.Np = 5632; d.kind = 1; d.Bt = wb + W_GU2; break;
    default: d.W = p.ffn2_down + (size_t)l * 2816 * 1024; d.ldw = 1024; d.K = 2816; d.Np = 1024; d.Bt = wb + W_DN2; break;
    }
    return d;
}
__device__ __forceinline__ void wconv_tile(const WDesc& d, int tile, float* lds) {
    const int tid = tidx();
    const int nkt = d.K >> 6;
    const int tk = tile % nkt, tn = tile / nkt;
    {
        const int n = (tn << 6) + (tid & 63);
        const int sc = srccol(d.kind, n);
#pragma unroll
        for (int r = 0; r < 16; ++r) {
            const int kk = (tid >> 6) + 4 * r;
            const int k = (tk << 6) + kk;
            float v = 0.f;
            if (sc >= 0) v = d.W[(size_t)k * d.ldw + sc];
            if (d.kgain) v *= d.kgain[k];
            lds[(tid & 63) * 65 + kk] = v;
        }
    }
    __syncthreads();
    {
        const int n = tid >> 2, k0 = (tid & 3) * 16;
        const float* s = lds + n * 65 + k0;
        u32x4 o0 = {pk2(s[0], s[1]), pk2(s[2], s[3]), pk2(s[4], s[5]), pk2(s[6], s[7])};
        u32x4 o1 = {pk2(s[8], s[9]), pk2(s[10], s[11]), pk2(s[12], s[13]), pk2(s[14], s[15])};
        bf16_t* dst = d.Bt + (size_t)((tn << 6) + n) * d.K + (tk << 6) + k0;
        *(u32x4*)dst = o0; *(u32x4*)(dst + 8) = o1;
    }
    __syncthreads();
}
__device__ __forceinline__ void phase_wconv(const Params& p, int l, unsigned char* lds) {
    int total = 0;
#pragma unroll 1
    for (int m = 0; m < 12; ++m) { WDesc d = wdesc(p, l, m); total += (d.K >> 6) * (d.Np >> 6); }
#pragma unroll 1
    for (int it = blockIdx.x; it < total; it += gridDim.x) {
        int r = it, m = 0;
#pragma unroll 1
        for (; m < 12; ++m) { WDesc d = wdesc(p, l, m); int c = (d.K >> 6) * (d.Np >> 6); if (r < c) break; r -= c; }
        WDesc d = wdesc(p, l, m);
        wconv_tile(d, r, (float*)lds);
    }
}

__device__ __forceinline__ void phase_rmsnorm(const float* x, const float* gain, bf16_t* outb, float* outf) {
    const int lane = tidx() & 63, wave = tidx() >> 6;
    f32x4 g[4];
#pragma unroll
    for (int j = 0; j < 4; ++j) g[j] = *(const f32x4*)(gain + lane * 4 + 256 * j);
#pragma unroll 1
    for (int row = blockIdx.x * 4 + wave; row < TOK; row += gridDim.x * 4) {
        const float* xr = x + (size_t)row * DM + lane * 4;
        f32x4 v[4]; float s = 0.f;
#pragma unroll
        for (int j = 0; j < 4; ++j) { v[j] = *(const f32x4*)(xr + 256 * j); s += v[j].x * v[j].x + v[j].y * v[j].y + v[j].z * v[j].z + v[j].w * v[j].w; }
        s = wave_sum(s);
        const float r = rsqrtf(s * (1.f / DM) + EPS);
#pragma unroll
        for (int j = 0; j < 4; ++j) {
            f32x4 o = v[j] * r * g[j];
            if (outb) { u32x2 w = {pk2(o.x, o.y), pk2(o.z, o.w)}; *(u32x2*)(outb + (size_t)row * DM + lane * 4 + 256 * j) = w; }
            else *(f32x4*)(outf + (size_t)row * DM + lane * 4 + 256 * j) = o;
        }
    }
}

constexpr int GLD = 72;
template <int NI>
__device__ __forceinline__ void gemm_core(const bf16_t* __restrict__ A, long lda, int acs, const bf16_t* __restrict__ Bt, int K,
                                          f32x16 (&acc)[2][NI], unsigned char* lds) {
    const int tid = tidx(), lane = tid & 63, wave = tid >> 6, wr = wave >> 1, wc = wave & 1;
    const int r = lane & 31, h = lane >> 5;
    constexpr int ABYTES = 128 * 128, BBYTES = 64 * NI * 128, STAGE = ABYTES + BBYTES;
    const int nk = K >> 6;
    const int lrow = tid >> 3, lp = tid & 7;
    auto issue = [&](int kc, int buf) {
        unsigned char* sb = lds + buf * STAGE;
#pragma unroll
        for (int i = 0; i < 4; ++i) {
            const int row = lrow + 32 * i, c = lp ^ ((row >> 1) & 7);
            __builtin_amdgcn_global_load_lds((const unsigned*)(A + (long)row * lda + (long)kc * acs + c * 8), (unsigned*)(sb + (i * 256 + tid) * 16), 16, 0, 0);
        }
#pragma unroll
        for (int i = 0; i < 2 * NI; ++i) {
            const int row = lrow + 32 * i, c = lp ^ ((row >> 1) & 7);
            __builtin_amdgcn_global_load_lds((const unsigned*)(Bt + (long)row * K + kc * 64 + c * 8), (unsigned*)(sb + ABYTES + (i * 256 + tid) * 16), 16, 0, 0);
        }
    };
    const int ra0 = wr * 64 + r, ra1 = ra0 + 32;
    const int fa0 = (ra0 >> 1) & 7, fa1 = (ra1 >> 1) & 7;
    __syncthreads();
    issue(0, 0);
#pragma unroll 1
    for (int kc = 0; kc < nk; ++kc) {
        asm volatile("s_waitcnt vmcnt(0)" ::: "memory");
        lds_barrier();
        const unsigned char* sa = lds + (kc & 1) * STAGE;
        const unsigned char* sbb = sa + ABYTES;
        bf16x8 af[4][2], bfr[4][NI];
#pragma unroll
        for (int ks = 0; ks < 4; ++ks) {
            const int c = 2 * ks + h;
            af[ks][0] = *(const bf16x8*)(sa + ra0 * 128 + ((c ^ fa0) << 4));
            af[ks][1] = *(const bf16x8*)(sa + ra1 * 128 + ((c ^ fa1) << 4));
#pragma unroll
            for (int ni = 0; ni < NI; ++ni) {
                const int rb = wc * 32 * NI + ni * 32 + r;
                bfr[ks][ni] = *(const bf16x8*)(sbb + rb * 128 + ((c ^ ((rb >> 1) & 7)) << 4));
            }
        }
        if (kc + 1 < nk) issue(kc + 1, (kc + 1) & 1);
#pragma unroll
        for (int ks = 0; ks < 4; ++ks)
#pragma unroll
            for (int ni = 0; ni < NI; ++ni) { acc[0][ni] = mfma32(af[ks][0], bfr[ks][ni], acc[0][ni]); acc[1][ni] = mfma32(af[ks][1], bfr[ks][ni], acc[1][ni]); }
    }
    asm volatile("s_waitcnt lgkmcnt(0)" ::: "memory");
}
__device__ __forceinline__ void gemm_big(const bf16_t* __restrict__ A, long lda, const bf16_t* __restrict__ Bt, int K, f32x16 (&acc)[2][4], unsigned char* lds) {
    const int tid = tidx(), lane = tid & 63, wave = tid >> 6, wr = wave >> 1, wc = wave & 1;
    const int r = lane & 31, h = lane >> 5;
    bf16_t* As = (bf16_t*)lds;
    bf16_t* Bs = As + 128 * GLD;
    const int nk = K >> 6;
    const int lrow = tid >> 3, lc = tid & 7;
    const bf16_t* ap = A + (long)lrow * lda + lc * 8;
    const bf16_t* bp = Bt + (long)lrow * K + lc * 8;
    u32x4 ra[4], rb[8];
    auto gload = [&](int kc) {
#pragma unroll
        for (int i = 0; i < 4; ++i) ra[i] = *(const u32x4*)(ap + (long)(32 * i) * lda + kc * 64);
#pragma unroll
        for (int i = 0; i < 8; ++i) rb[i] = *(const u32x4*)(bp + (long)(32 * i) * K + kc * 64);
    };
    auto lstore = [&]() {
#pragma unroll
        for (int i = 0; i < 4; ++i) *(u32x4*)(As + (lrow + 32 * i) * GLD + lc * 8) = ra[i];
#pragma unroll
        for (int i = 0; i < 8; ++i) *(u32x4*)(Bs + (lrow + 32 * i) * GLD + lc * 8) = rb[i];
    };
    const bf16_t* Ac = As + (wr * 64 + r) * GLD + h * 8;
    const bf16_t* Bc = Bs + (wc * 128 + r) * GLD + h * 8;
    gload(0);
    __syncthreads();
    lstore();
    if (nk > 1) gload(1);
    lds_barrier();
#pragma unroll 1
    for (int kc = 0; kc < nk; ++kc) {
        bf16x8 af[2][2], bfr[2][4];
        af[0][0] = *(const bf16x8*)(Ac); af[0][1] = *(const bf16x8*)(Ac + 32 * GLD);
#pragma unroll
        for (int ni = 0; ni < 4; ++ni) bfr[0][ni] = *(const bf16x8*)(Bc + ni * 32 * GLD);
        __builtin_amdgcn_s_setprio(1);
#pragma unroll
        for (int ks = 0; ks < 4; ++ks) {
            const int cb = ks & 1, nb = cb ^ 1;
            if (ks < 3) {
                af[nb][0] = *(const bf16x8*)(Ac + (ks + 1) * 16); af[nb][1] = *(const bf16x8*)(Ac + 32 * GLD + (ks + 1) * 16);
#pragma unroll
                for (int ni = 0; ni < 4; ++ni) bfr[nb][ni] = *(const bf16x8*)(Bc + ni * 32 * GLD + (ks + 1) * 16);
            }
            __builtin_amdgcn_sched_barrier(0);
#pragma unroll
            for (int ni = 0; ni < 4; ++ni) { acc[0][ni] = mfma32(af[cb][0], bfr[cb][ni], acc[0][ni]); acc[1][ni] = mfma32(af[cb][1], bfr[cb][ni], acc[1][ni]); }
            __builtin_amdgcn_sched_barrier(0);
        }
        __builtin_amdgcn_s_setprio(0);
        lds_barrier();
        if (kc + 1 < nk) {
            lstore();
            if (kc + 2 < nk) gload(kc + 2);
            lds_barrier();
        }
    }
}
#define ZERO_ACC4(acc) { _Pragma("unroll") for (int _a = 0; _a < 2; ++_a) { _Pragma("unroll") for (int _b = 0; _b < 4; ++_b) { _Pragma("unroll") for (int _c = 0; _c < 16; ++_c) acc[_a][_b][_c] = 0.f; } } }
__device__ __forceinline__ bool tile_at(int k, int NPM, int NPN, int& pm, int& pn) {
    const int nb = gridDim.x >> 3, x = blockIdx.x & 7, jb = blockIdx.x >> 3;
    const int t = jb + k * nb, perx = (NPM >> 3) * NPN;
    if (t >= perx) return false;
    const int pmg = t / (8 * NPN), rem = t - pmg * 8 * NPN;
    pn = rem >> 3; pm = x * (NPM >> 3) + pmg * 8 + (rem & 7);
    return true;
}
#define ZERO_ACC(acc) { _Pragma("unroll") for (int _a = 0; _a < 2; ++_a) { _Pragma("unroll") for (int _b = 0; _b < 2; ++_b) { _Pragma("unroll") for (int _c = 0; _c < 16; ++_c) acc[_a][_b][_c] = 0.f; } } }

__device__ __forceinline__ void phase_gu(const Params& p, const bf16_t* wgu, unsigned char* lds) {
    const bf16_t* hb = (const bf16_t*)(p.ws + OFF_HB);
    bf16_t* act = (bf16_t*)(p.ws + OFF_BIG);
    const int lane = tidx() & 63, wave = tidx() >> 6, wr = wave >> 1, wc = wave & 1, r = lane & 31, h = lane >> 5;
    constexpr int NPN = 5632 / 256;
    int pm, pn;
#pragma unroll 1
    for (int k = 0; tile_at(k, TOK / 128, NPN, pm, pn); ++k) {
        f32x16 acc[2][4]; ZERO_ACC4(acc);
        gemm_big(hb + (size_t)pm * 128 * DM, DM, wgu + (size_t)pn * 256 * DM, DM, acc, lds);
#pragma unroll
        for (int gq = 0; gq < 2; ++gq) {
            const int a = pn * 128 + wc * 64 + gq * 32 + r;
#pragma unroll
            for (int mi = 0; mi < 2; ++mi)
#pragma unroll
                for (int reg = 0; reg < 16; ++reg) {
                    const int m = pm * 128 + wr * 64 + mi * 32 + (reg & 3) + 8 * (reg >> 2) + 4 * h;
                    const float g = acc[mi][2 * gq][reg], u = acc[mi][2 * gq + 1][reg];
                    const float v = siluf(g) * u;
                    act[(size_t)m * DFF + a] = (bf16_t)(pk2(v, 0.f) & 0xffff);
                }
        }
    }
}
__device__ __forceinline__ void phase_resid(const Params& p, const bf16_t* A, long lda, int mrows, const bf16_t* Bt, int K, float* xres, float scale, unsigned char* lds) {
    const int lane = tidx() & 63, wave = tidx() >> 6, wr = wave >> 1, wc = wave & 1, r = lane & 31, h = lane >> 5;
    int pm, pn;
#pragma unroll 1
    for (int k = 0; tile_at(k, mrows / 128, 4, pm, pn); ++k) {
        f32x16 acc[2][4]; ZERO_ACC4(acc);
        gemm_big(A + (size_t)pm * 128 * lda, lda, Bt + (size_t)pn * 256 * K, K, acc, lds);
#pragma unroll
        for (int mi = 0; mi < 2; ++mi)
#pragma unroll
            for (int ni = 0; ni < 4; ++ni)
#pragma unroll
                for (int reg = 0; reg < 16; ++reg) {
                    const int m = pm * 128 + wr * 64 + mi * 32 + (reg & 3) + 8 * (reg >> 2) + 4 * h;
                    const int n = pn * 256 + wc * 128 + ni * 32 + r;
                    float* q = xres + (size_t)m * DM + n;
                    *q = *q + scale * acc[mi][ni][reg];
                }
    }
}
__device__ __forceinline__ void phase_win(const Params& p, int b, unsigned char* lds) {
    const bf16_t* hb = (const bf16_t*)(p.ws + OFF_HB) + (size_t)b * TH * DM;
    const bf16_t* wt = (const bf16_t*)(p.ws + OFF_WB) + W_IN;
    bf16_t* PB = (bf16_t*)(p.ws + OFF_PB);
    bf16_t* VTF = (bf16_t*)(p.ws + OFF_VTF);
    float* S32 = (float*)(p.ws + OFF_S32);
    const int lane = tidx() & 63, wave = tidx() >> 6, wr = wave >> 1, wc = wave & 1, r = lane & 31, h = lane >> 5;
    const float qscale = 0.125f * LOG2E;
    int pm, pn;
#pragma unroll 1
    for (int k = 0; tile_at(k, TH / 128, 16, pm, pn); ++k) {
        f32x16 acc[2][4]; ZERO_ACC4(acc);
        gemm_big(hb + (size_t)pm * 128 * DM, DM, wt + (size_t)pn * 256 * DM, DM, acc, lds);
#pragma unroll
        for (int ni = 0; ni < 4; ++ni) {
            const int nb = pn * 256 + wc * 128 + ni * 32;
            const int n = nb + r;
#pragma unroll
            for (int mi = 0; mi < 2; ++mi) {
                const int mb = pm * 128 + wr * 64 + mi * 32 + 4 * h;
                if (nb >= 1024 && nb < 1536) {
#pragma unroll
                    for (int g = 0; g < 4; ++g) {
                        u32x2 w = {pk2(acc[mi][ni][4 * g], acc[mi][ni][4 * g + 1]), pk2(acc[mi][ni][4 * g + 2], acc[mi][ni][4 * g + 3])};
                        *(u32x2*)(VTF + (size_t)(n - 1024) * TH + mb + 8 * g) = w;
                    }
                } else if (nb >= 3968) {
                    const int j = n - 3968;
                    if (j < 64) {
#pragma unroll
                        for (int reg = 0; reg < 16; ++reg) S32[(size_t)(mb + (reg & 3) + 8 * (reg >> 2)) * 64 + j] = acc[mi][ni][reg];
                    }
                } else {
                    const float sc = (nb < 512) ? qscale : 1.f;
#pragma unroll
                    for (int reg = 0; reg < 16; ++reg)
                        PB[(size_t)(mb + (reg & 3) + 8 * (reg >> 2)) * PBW + n] = (bf16_t)(pk2(acc[mi][ni][reg] * sc, 0.f) & 0xffff);
                }
            }
        }
    }
}

__device__ __forceinline__ void fox_cumsum_item(const Params& p, int l, int hd, unsigned char* lds) {
    const float* S32 = (const float*)(p.ws + OFF_S32);
    float* CF = (float*)(p.ws + OFF_CF) + (size_t)hd * TH;
    float* sw = (float*)lds;
    const int tid = tidx(), lane = tid & 63, wave = tid >> 6;
    const float bf = p.fox_bf[l * 8 + hd];
    float loc = 0.f;
#pragma unroll 4
    for (int e = 0; e < 64; ++e) { float x = S32[(size_t)(tid * 64 + e) * 64 + hd] + bf; loc += fminf(x, 0.f) - log1pf(__expf(-fabsf(x))); }
    float v = loc;
#pragma unroll
    for (int o = 1; o < 64; o <<= 1) { float u = __shfl_up(v, o); if (lane >= o) v += u; }
    if (lane == 63) sw[wave] = v;
    __syncthreads();
    float base = v - loc;
    for (int w = 0; w < wave; ++w) base += sw[w];
    float run = base;
#pragma unroll 4
    for (int e = 0; e < 64; ++e) { float x = S32[(size_t)(tid * 64 + e) * 64 + hd] + bf; run += fminf(x, 0.f) - log1pf(__expf(-fabsf(x))); CF[tid * 64 + e] = run * LOG2E; }
    __syncthreads();
}
__device__ __forceinline__ void mla_rows_item(const Params& p, int b, int item, unsigned* nrm) {
    const bf16_t* PB = (const bf16_t*)(p.ws + OFF_PB);
    const float* S32 = (const float*)(p.ws + OFF_S32);
    const float* rope = (const float*)(p.ws + OFF_ROPE);
    float* RQ = (float*)(p.ws + OFF_RQ); float* RKV = (float*)(p.ws + OFF_RKV);
    bf16_t* KM = (bf16_t*)(p.ws + OFF_KM);
    const int lane = tidx() & 63, wave = tidx() >> 6;
    float qmx = 0.f, kmx = 0.f;
#pragma unroll 1
    for (int e = 0; e < 16; ++e) {
        const int m = item * 64 + wave * 16 + e;
        u32x2 cq = *(const u32x2*)(PB + (size_t)m * PBW + PB_CQ + lane * 4);
        uint32_t ck = *(const uint32_t*)(PB + (size_t)m * PBW + PB_CKV + lane * 2);
        float s1 = bflo(cq.x) * bflo(cq.x) + bfhi(cq.x) * bfhi(cq.x) + bflo(cq.y) * bflo(cq.y) + bfhi(cq.y) * bfhi(cq.y);
        float s2 = bflo(ck) * bflo(ck) + bfhi(ck) * bfhi(ck);
        s1 = wave_sum(s1); s2 = wave_sum(s2);
        if (lane == 0) { RQ[m] = rsqrtf(s1 * (1.f / 256.f) + EPS); RKV[m] = rsqrtf(s2 * (1.f / 128.f) + EPS); }
        {
            const u32x4 fq = *(const u32x4*)(PB + (size_t)m * PBW + lane * 8);
            const u32x4 fk = *(const u32x4*)(PB + (size_t)m * PBW + 512 + lane * 8);
            float a = bflo(fq.x) * bflo(fq.x) + bfhi(fq.x) * bfhi(fq.x) + bflo(fq.y) * bflo(fq.y) + bfhi(fq.y) * bfhi(fq.y)
                    + bflo(fq.z) * bflo(fq.z) + bfhi(fq.z) * bfhi(fq.z) + bflo(fq.w) * bflo(fq.w) + bfhi(fq.w) * bfhi(fq.w);
            float c = bflo(fk.x) * bflo(fk.x) + bfhi(fk.x) * bfhi(fk.x) + bflo(fk.y) * bflo(fk.y) + bfhi(fk.y) * bfhi(fk.y)
                    + bflo(fk.z) * bflo(fk.z) + bfhi(fk.z) * bfhi(fk.z) + bflo(fk.w) * bflo(fk.w) + bfhi(fk.w) * bfhi(fk.w);
            a += __shfl_xor(a, 1); a += __shfl_xor(a, 2); a += __shfl_xor(a, 4);
            c += __shfl_xor(c, 1); c += __shfl_xor(c, 2); c += __shfl_xor(c, 4);
            qmx = fmaxf(qmx, a); kmx = fmaxf(kmx, c);
        }
        const int hd = lane >> 3, j0 = (lane & 7) * 2;
        const float* rp = rope + (size_t)(b * TH + m) * 32;
        const float* kr = S32 + (size_t)m * 64 + 32;
        float x1a = kr[j0], x1b = kr[j0 + 1], x2a = kr[16 + j0], x2b = kr[16 + j0 + 1];
        float ca = rp[j0], cb = rp[j0 + 1], sa = rp[16 + j0], sb = rp[16 + j0 + 1];
        bf16_t* dst = KM + ((size_t)m * 8 + hd) * 96 + 64;
        *(uint32_t*)(dst + j0) = pk2(x1a * ca - x2a * sa, x1b * cb - x2b * sb);
        *(uint32_t*)(dst + 16 + j0) = pk2(x2a * ca + x1a * sa, x2b * cb + x1b * sb);
    }
    if ((lane & 7) == 0) { atomicMax(&nrm[lane >> 3], __float_as_uint(qmx)); atomicMax(&nrm[8 + (lane >> 3)], __float_as_uint(kmx)); }
}

constexpr int DLD = 68;
__device__ __forceinline__ void mm64(const float* At, const float* B, float (&acc)[4][4], int ty, int tx) {
    f32x2 c2[4][2];
#pragma unroll
    for (int rr = 0; rr < 4; ++rr) { c2[rr][0] = (f32x2){acc[rr][0], acc[rr][1]}; c2[rr][1] = (f32x2){acc[rr][2], acc[rr][3]}; }
#pragma unroll 8
    for (int k = 0; k < 64; ++k) {
        const f32x4 a = *(const f32x4*)(At + k * DLD + 4 * ty);
        const f32x4 b = *(const f32x4*)(B + k * DLD + 4 * tx);
        const f32x2 b01 = {b.x, b.y}, b23 = {b.z, b.w};
#pragma unroll
        for (int rr = 0; rr < 4; ++rr) {
            const f32x2 a2 = {a[rr], a[rr]};
            c2[rr][0] = __builtin_elementwise_fma(a2, b01, c2[rr][0]);
            c2[rr][1] = __builtin_elementwise_fma(a2, b23, c2[rr][1]);
        }
    }
#pragma unroll
    for (int rr = 0; rr < 4; ++rr) { acc[rr][0] = c2[rr][0].x; acc[rr][1] = c2[rr][0].y; acc[rr][2] = c2[rr][1].x; acc[rr][3] = c2[rr][1].y; }
}
#define ZERO44(a) { _Pragma("unroll") for (int _i = 0; _i < 4; ++_i) { _Pragma("unroll") for (int _j = 0; _j < 4; ++_j) a[_i][_j] = 0.f; } }

__device__ __forceinline__ void dn_conv16(const bf16_t* PB, const float* cw, int t0, int i, int col, int ch, float (&o)[16]) {
#pragma unroll
    for (int e = 0; e < 16; ++e) o[e] = 0.f;
#pragma unroll
    for (int tap = 0; tap < 4; ++tap) {
        const int mm = t0 + i - 3 + tap;
        if (mm >= 0) {
            const u32x4 x0 = *(const u32x4*)(PB + (size_t)mm * PBW + col);
            const u32x4 x1 = *(const u32x4*)(PB + (size_t)mm * PBW + col + 8);
            const float* w = cw + tap * 1536 + ch;
            const f32x4 w0 = *(const f32x4*)w, w1 = *(const f32x4*)(w + 4), w2 = *(const f32x4*)(w + 8), w3 = *(const f32x4*)(w + 12);
            o[0] += w0.x * bflo(x0.x); o[1] += w0.y * bfhi(x0.x); o[2] += w0.z * bflo(x0.y); o[3] += w0.w * bfhi(x0.y);
            o[4] += w1.x * bflo(x0.z); o[5] += w1.y * bfhi(x0.z); o[6] += w1.z * bflo(x0.w); o[7] += w1.w * bfhi(x0.w);
            o[8] += w2.x * bflo(x1.x); o[9] += w2.y * bfhi(x1.x); o[10] += w2.z * bflo(x1.y); o[11] += w2.w * bfhi(x1.y);
            o[12] += w3.x * bflo(x1.z); o[13] += w3.y * bfhi(x1.z); o[14] += w3.z * bflo(x1.w); o[15] += w3.w * bfhi(x1.w);
        }
    }
#pragma unroll
    for (int e = 0; e < 16; ++e) o[e] = siluf(o[e]);
}

__device__ __forceinline__ void dn1_item(const Params& p, int l, int item, unsigned char* lds) {
    const bf16_t* PB = (const bf16_t*)(p.ws + OFF_PB);
    const float* S32 = (const float*)(p.ws + OFF_S32);
    float* DNA = (float*)(p.ws + OFF_DNA) + (size_t)item * 4096;
    float* DNB = (float*)(p.ws + OFF_DNB) + (size_t)item * 4096;
    float* DNQ = (float*)(p.ws + OFF_DNQ) + (size_t)item * 4096;
    float* DNO = (float*)(p.ws + OFF_DNO) + (size_t)item * 4096;
    float* B0 = (float*)lds; float* B1 = B0 + 64 * DLD; float* B2 = B1 + 64 * DLD; float* B3 = B2 + 64 * DLD;
    float* sgc = B3 + 64 * DLD; float* sbeta = sgc + 64;
    const int tid = tidx(), lane = tid & 63, wave = tid >> 6;
    const int i = tid >> 2, seg = tid & 3, d0 = seg * 16, ty = tid >> 4, tx = tid & 15;
    const int cchunk = item >> 3, hd = item & 7, t0 = cchunk * 64;
    const float* cw = p.dn_conv + (size_t)l * 4 * 1536;
    float qn[16], kn[16], vv[16];
    dn_conv16(PB, cw, t0, i, PB_DN + hd * 64 + d0, hd * 64 + d0, qn);
    dn_conv16(PB, cw, t0, i, PB_DN + 512 + hd * 64 + d0, 512 + hd * 64 + d0, kn);
    dn_conv16(PB, cw, t0, i, PB_DN + 1024 + hd * 64 + d0, 1024 + hd * 64 + d0, vv);
    {
        float sq = 0.f, sk = 0.f;
#pragma unroll
        for (int e = 0; e < 16; ++e) { sq += qn[e] * qn[e]; sk += kn[e] * kn[e]; }
        sq += __shfl_xor(sq, 1); sq += __shfl_xor(sq, 2);
        sk += __shfl_xor(sk, 1); sk += __shfl_xor(sk, 2);
        const float rq = rsqrtf(sq + EPS) * 0.125f, rk = rsqrtf(sk + EPS);
#pragma unroll
        for (int e = 0; e < 16; ++e) { qn[e] *= rq; kn[e] *= rk; }
    }
    __syncthreads();
#pragma unroll
    for (int e = 0; e < 16; ++e) { B0[(d0 + e) * DLD + i] = kn[e]; B1[(d0 + e) * DLD + i] = qn[e]; }
    if (seg == 0) {
        const float a = S32[(size_t)(t0 + i) * 64 + 16 + hd], bb = S32[(size_t)(t0 + i) * 64 + 8 + hd];
        const float xx = a + p.dn_dtb[l * 8 + hd];
        const float sp = (xx > 20.f) ? xx : log1pf(__expf(xx));
        sgc[i] = -__expf(p.dn_alog[l * 8 + hd]) * sp;
        sbeta[i] = sigmf(bb);
    }
    __syncthreads();
    if (wave == 0) {
        float v = sgc[lane];
#pragma unroll
        for (int o = 1; o < 64; o <<= 1) { float u = __shfl_up(v, o); if (lane >= o) v += u; }
        sgc[lane] = v;
    }
    __syncthreads();
    const float gci = sgc[i], beti = sbeta[i], gcl = sgc[63];
    const float gl = __expf(gcl);
    {
        float a1[4][4], a2[4][4]; ZERO44(a1); ZERO44(a2);
        mm64(B0, B0, a1, ty, tx);
        mm64(B1, B0, a2, ty, tx);
#pragma unroll
        for (int rr = 0; rr < 4; ++rr) {
            const int ii = 4 * ty + rr; const float gi = sgc[ii], bi = sbeta[ii];
#pragma unroll
            for (int cc = 0; cc < 4; ++cc) {
                const int jj = 4 * tx + cc; const float gj = sgc[jj];
                const float dec = (ii >= jj) ? __expf(gi - gj) : 0.f;
                B2[ii * DLD + jj] = (ii > jj) ? bi * a1[rr][cc] * dec : 0.f;
                B3[jj * DLD + ii] = a2[rr][cc] * dec;
            }
        }
    }
    __syncthreads();
    {
        const float s = beti * __expf(gci);
#pragma unroll
        for (int e = 0; e < 16; e += 4) { f32x4 w = {kn[e] * s, kn[e + 1] * s, kn[e + 2] * s, kn[e + 3] * s}; *(f32x4*)(B1 + i * DLD + d0 + e) = w; }
    }
    {
        float* Xs = sbeta + 64;
#pragma unroll
        for (int e = 0; e < 16; e += 4) { f32x4 z = {0.f, 0.f, 0.f, 0.f}; *(f32x4*)(B0 + i * DLD + d0 + e) = z; }
        __syncthreads();
        if (lane < 16) {
            const int base = 16 * wave;
            float t[16];
#pragma unroll
            for (int rr = 0; rr < 16; ++rr) {
                float sacc = (rr == lane) ? 1.f : 0.f;
#pragma unroll
                for (int m = 0; m < rr; ++m) sacc -= B2[(base + rr) * DLD + base + m] * t[m];
                t[rr] = sacc;
            }
#pragma unroll
            for (int rr = 0; rr < 16; rr += 4) { f32x4 w = {t[rr], t[rr + 1], t[rr + 2], t[rr + 3]}; *(f32x4*)(B0 + (base + lane) * DLD + base + rr) = w; }
        }
        __syncthreads();
        const int br = tid >> 4, bc = tid & 15;
#pragma unroll 1
        for (int bi = 1; bi < 4; ++bi) {
#pragma unroll 1
            for (int bj = 0; bj < bi; ++bj) {
                float x = 0.f;
#pragma unroll 1
                for (int bk = bj; bk < bi; ++bk) {
                    const float* mp = B2 + (16 * bi + br) * DLD + 16 * bk;
                    const float* tp = B0 + (16 * bj + bc) * DLD + 16 * bk;
#pragma unroll
                    for (int m = 0; m < 16; m += 4) {
                        const f32x4 a = *(const f32x4*)(mp + m), t4 = *(const f32x4*)(tp + m);
                        x += a.x * t4.x + a.y * t4.y + a.z * t4.z + a.w * t4.w;
                    }
                }
                Xs[bj * 256 + br * 16 + bc] = x;
            }
            __syncthreads();
#pragma unroll 1
            for (int bj = 0; bj < bi; ++bj) {
                float y = 0.f;
#pragma unroll
                for (int m = 0; m < 16; ++m) y += B0[(16 * bi + m) * DLD + 16 * bi + br] * Xs[bj * 256 + m * 16 + bc];
                B0[(16 * bj + bc) * DLD + 16 * bi + br] = -y;
            }
            __syncthreads();
        }
    }
    __syncthreads();
    float wacc[4][4], uacc[4][4]; ZERO44(wacc); ZERO44(uacc);
    mm64(B0, B1, wacc, ty, tx);
#pragma unroll
    for (int e = 0; e < 16; e += 4) { f32x4 w = {vv[e] * beti, vv[e + 1] * beti, vv[e + 2] * beti, vv[e + 3] * beti}; *(f32x4*)(B2 + i * DLD + d0 + e) = w; }
    __syncthreads();
    mm64(B0, B2, uacc, ty, tx);
    __syncthreads();
#pragma unroll
    for (int rr = 0; rr < 4; ++rr) {
        f32x4 w = {wacc[rr][0], wacc[rr][1], wacc[rr][2], wacc[rr][3]}; *(f32x4*)(B1 + (4 * ty + rr) * DLD + 4 * tx) = w;
        f32x4 u = {uacc[rr][0], uacc[rr][1], uacc[rr][2], uacc[rr][3]}; *(f32x4*)(B2 + (4 * ty + rr) * DLD + 4 * tx) = u;
    }
    {
        const float s = __expf(gcl - gci);
#pragma unroll
        for (int e = 0; e < 16; e += 4) { f32x4 w = {kn[e] * s, kn[e + 1] * s, kn[e + 2] * s, kn[e + 3] * s}; *(f32x4*)(B0 + i * DLD + d0 + e) = w; }
    }
    __syncthreads();
    {
        float a1[4][4]; ZERO44(a1);
        mm64(B0, B1, a1, ty, tx);
#pragma unroll
        for (int rr = 0; rr < 4; ++rr) {
            f32x4 w;
#pragma unroll
            for (int cc = 0; cc < 4; ++cc) w[cc] = ((4 * ty + rr) == (4 * tx + cc) ? gl : 0.f) - a1[rr][cc];
            *(f32x4*)(DNA + (4 * ty + rr) * 64 + 4 * tx) = w;
        }
        ZERO44(a1);
        mm64(B0, B2, a1, ty, tx);
#pragma unroll
        for (int rr = 0; rr < 4; ++rr) { f32x4 w = {a1[rr][0], a1[rr][1], a1[rr][2], a1[rr][3]}; *(f32x4*)(DNB + (4 * ty + rr) * 64 + 4 * tx) = w; }
    }
    float hacc[4][4]; ZERO44(hacc);
    mm64(B1, B3, hacc, ty, tx);
    {
        float a1[4][4]; ZERO44(a1);
        mm64(B3, B2, a1, ty, tx);
#pragma unroll
        for (int rr = 0; rr < 4; ++rr) { f32x4 w = {a1[rr][0], a1[rr][1], a1[rr][2], a1[rr][3]}; *(f32x4*)(DNO + (4 * ty + rr) * 64 + 4 * tx) = w; }
    }
    __syncthreads();
    {
        const float s = __expf(gci);
#pragma unroll
        for (int e = 0; e < 16; e += 4) { f32x4 w = {qn[e] * s, qn[e + 1] * s, qn[e + 2] * s, qn[e + 3] * s}; *(f32x4*)(B0 + i * DLD + d0 + e) = w; }
    }
    __syncthreads();
#pragma unroll
    for (int rr = 0; rr < 4; ++rr) {
        f32x4 w;
#pragma unroll
        for (int cc = 0; cc < 4; ++cc) w[cc] = B0[(4 * tx + cc) * DLD + 4 * ty + rr] - hacc[rr][cc];
        *(f32x4*)(DNQ + (4 * ty + rr) * 64 + 4 * tx) = w;
    }
    __syncthreads();
}

__device__ __forceinline__ void split8(const f32x4 a, const f32x4 b, bf16x8& hi, bf16x8& lo) {
    const uint32_t h0 = pk2(a.x, a.y), h1 = pk2(a.z, a.w), h2 = pk2(b.x, b.y), h3 = pk2(b.z, b.w);
    const uint32_t l0 = pk2(a.x - bflo(h0), a.y - bfhi(h0)), l1 = pk2(a.z - bflo(h1), a.w - bfhi(h1));
    const uint32_t l2 = pk2(b.x - bflo(h2), b.y - bfhi(h2)), l3 = pk2(b.z - bflo(h3), b.w - bfhi(h3));
    hi = mk8(h0, h1, h2, h3); lo = mk8(l0, l1, l2, l3);
}
constexpr int ALD = 72;
__device__ __forceinline__ void dn2_block(const Params& p, int hd, unsigned char* lds) {
    const float* DNA = (const float*)(p.ws + OFF_DNA);
    const float* DNB = (const float*)(p.ws + OFF_DNB);
    float* DNS = (float*)(p.ws + OFF_DNS);
    const int tid = tidx(), lane = tid & 63, vg = tid >> 6, c = lane & 15, q = lane >> 4;
    bf16_t* Ah = (bf16_t*)lds;
    f32x4 st[4];
#pragma unroll
    for (int mt = 0; mt < 4; ++mt) st[mt] = (f32x4){0.f, 0.f, 0.f, 0.f};
    f32x4 ga[3][4], gb[3][4];
    auto gload = [&](int d, int n) {
        const float* Ab = DNA + (size_t)(n * 8 + hd) * 4096; const float* Bb = DNB + (size_t)(n * 8 + hd) * 4096;
#pragma unroll
        for (int e = 0; e < 4; ++e) { const int id = tid + 256 * e; ga[d][e] = *(const f32x4*)(Ab + (id >> 4) * 64 + (id & 15) * 4); }
#pragma unroll
        for (int mt = 0; mt < 4; ++mt)
#pragma unroll
            for (int ii = 0; ii < 4; ++ii) gb[d][mt][ii] = Bb[(16 * mt + 4 * q + ii) * 64 + 16 * vg + c];
    };
    auto lstore = [&](int d, int buf) {
#pragma unroll
        for (int e = 0; e < 4; ++e) {
            const int id = tid + 256 * e, row = id >> 4, k = (id & 15) * 4;
            const int pos = (k >> 5) * 32 + ((k >> 2) & 3) * 8 + ((k >> 4) & 1) * 4;
            const f32x4 a = ga[d][e];
            const uint32_t h0 = pk2(a.x, a.y), h1 = pk2(a.z, a.w);
            const uint32_t l0 = pk2(a.x - bflo(h0), a.y - bfhi(h0)), l1 = pk2(a.z - bflo(h1), a.w - bfhi(h1));
            u32x2 hv = {h0, h1}, lv = {l0, l1};
            *(u32x2*)(Ah + (buf * 2 + 0) * 64 * ALD + row * ALD + pos) = hv;
            *(u32x2*)(Ah + (buf * 2 + 1) * 64 * ALD + row * ALD + pos) = lv;
        }
    };
    auto step = [&](int d, int n) {
        if (n + 1 < 256) lstore((d + 1) % 3, (n + 1) & 1);
        float* Sb = DNS + (size_t)(n * 8 + hd) * 4096;
#pragma unroll
        for (int mt = 0; mt < 4; ++mt)
#pragma unroll
            for (int ii = 0; ii < 4; ++ii) Sb[(16 * mt + 4 * q + ii) * 64 + 16 * vg + c] = st[mt][ii];
        bf16x8 shi[2], slo[2];
        split8(st[0], st[1], shi[0], slo[0]);
        split8(st[2], st[3], shi[1], slo[1]);
        const bf16_t* Ahi = Ah + ((n & 1) * 2 + 0) * 64 * ALD + c * ALD + q * 8;
        const bf16_t* Alo = Ah + ((n & 1) * 2 + 1) * 64 * ALD + c * ALD + q * 8;
#pragma unroll
        for (int mt = 0; mt < 4; ++mt) {
            f32x4 acc = gb[d][mt];
#pragma unroll
            for (int s = 0; s < 2; ++s) {
                const bf16x8 ahi = *(const bf16x8*)(Ahi + 16 * mt * ALD + 32 * s);
                const bf16x8 alo = *(const bf16x8*)(Alo + 16 * mt * ALD + 32 * s);
                acc = mfma16(ahi, shi[s], acc);
                acc = mfma16(ahi, slo[s], acc);
                acc = mfma16(alo, shi[s], acc);
            }
            st[mt] = acc;
        }
        if (n + 3 < 256) gload(d, n + 3);
        lds_barrier();
    };
    gload(0, 0); gload(1, 1); gload(2, 2);
    __syncthreads();
    lstore(0, 0);
    __syncthreads();
#pragma unroll 1
    for (int n3 = 0; n3 < 255; n3 += 3) { step(0, n3); step(1, n3 + 1); step(2, n3 + 2); }
    step(0, 255);
}
__device__ __forceinline__ void dn3_item(const Params& p, int l, int item, unsigned char* lds) {
    bf16_t* PB = (bf16_t*)(p.ws + OFF_PB);
    const float* DNQ = (const float*)(p.ws + OFF_DNQ) + (size_t)item * 4096;
    const float* DNS = (const float*)(p.ws + OFF_DNS) + (size_t)item * 4096;
    const float* DNO = (const float*)(p.ws + OFF_DNO) + (size_t)item * 4096;
    float* B0 = (float*)lds; float* B1 = B0 + 64 * DLD;
    const int tid = tidx(), ty = tid >> 4, tx = tid & 15;
    const int cchunk = item >> 3, hd = item & 7, t0 = cchunk * 64;
    __syncthreads();
#pragma unroll
    for (int e = 0; e < 4; ++e) {
        const int id = tid + 256 * e, row = id >> 4, c4 = (id & 15) * 4;
        *(f32x4*)(B0 + row * DLD + c4) = *(const f32x4*)(DNQ + row * 64 + c4);
        *(f32x4*)(B1 + row * DLD + c4) = *(const f32x4*)(DNS + row * 64 + c4);
    }
    __syncthreads();
    float acc[4][4];
#pragma unroll
    for (int rr = 0; rr < 4; ++rr) { const f32x4 o = *(const f32x4*)(DNO + (4 * ty + rr) * 64 + 4 * tx); acc[rr][0] = o.x; acc[rr][1] = o.y; acc[rr][2] = o.z; acc[rr][3] = o.w; }
    mm64(B0, B1, acc, ty, tx);
    const f32x4 gn = *(const f32x4*)(p.dn_onorm + l * 64 + 4 * tx);
#pragma unroll
    for (int rr = 0; rr < 4; ++rr) {
        float ss = acc[rr][0] * acc[rr][0] + acc[rr][1] * acc[rr][1] + acc[rr][2] * acc[rr][2] + acc[rr][3] * acc[rr][3];
        ss += __shfl_xor(ss, 1); ss += __shfl_xor(ss, 2); ss += __shfl_xor(ss, 4); ss += __shfl_xor(ss, 8);
        const float rs = rsqrtf(ss * (1.f / 64.f) + EPS);
        const size_t rowoff = (size_t)(t0 + 4 * ty + rr) * PBW + PB_DN + hd * 64 + 4 * tx;
        const u32x2 z = *(const u32x2*)(PB + rowoff + 1536);
        const float o0 = acc[rr][0] * rs * gn.x * siluf(bflo(z.x)), o1 = acc[rr][1] * rs * gn.y * siluf(bfhi(z.x));
        const float o2 = acc[rr][2] * rs * gn.z * siluf(bflo(z.y)), o3 = acc[rr][3] * rs * gn.w * siluf(bfhi(z.y));
        u32x2 w = {pk2(o0, o1), pk2(o2, o3)};
        *(u32x2*)(PB + rowoff) = w;
    }
}

__device__ __forceinline__ void mla_up_tile(const Params& p, int b, int it, unsigned char* lds) {
    const bf16_t* PB = (const bf16_t*)(p.ws + OFF_PB);
    const bf16_t* wb = (const bf16_t*)(p.ws + OFF_WB);
    const int lane = tidx() & 63, wave = tidx() >> 6, wr = wave >> 1, wc = wave & 1, r = lane & 31, h = lane >> 5;
    f32x16 acc[2][4]; ZERO_ACC4(acc);
    if (it < 384) {
        const int pn = it % 3, pm = it / 3;
        gemm_big(PB + (size_t)pm * 128 * PBW + PB_CQ, PBW, wb + W_UQ + (size_t)pn * 256 * 256, 256, acc, lds);
        const float* RQ = (const float*)(p.ws + OFF_RQ);
        const float* rope = (const float*)(p.ws + OFF_ROPE);
        bf16_t* QF = (bf16_t*)(p.ws + OFF_QF);
        const float qsc = 0.10206207261596575f * LOG2E;
#pragma unroll
        for (int mi = 0; mi < 2; ++mi)
#pragma unroll
            for (int reg = 0; reg < 16; ++reg) {
                const int m = pm * 128 + wr * 64 + mi * 32 + (reg & 3) + 8 * (reg >> 2) + 4 * h;
                const float rq = RQ[m] ;
                const float* rp = rope + (size_t)(b * TH + m) * 32;
                const float cs = rp[r & 15], sn = rp[16 + (r & 15)];
#pragma unroll
                for (int ni = 0; ni < 4; ++ni) {
                    const int nb = pn * 256 + wc * 128 + ni * 32, n = nb + r;
                    float v = acc[mi][ni][reg] * rq;
                    if (((nb >> 5) % 3) == 2) {
                        const float o = __builtin_bit_cast(float, __builtin_amdgcn_ds_swizzle(__builtin_bit_cast(int, v), 0x401f));
                        v = (r < 16) ? (v * cs - o * sn) : (v * cs + o * sn);
                    }
                    QF[(size_t)m * 768 + n] = (bf16_t)(pk2(v * qsc, 0.f) & 0xffff);
                }
            }
    } else {
        const int j = it - 384, pn = j & 3, pm = j >> 2;
        gemm_big(PB + (size_t)pm * 128 * PBW + PB_CKV, PBW, wb + W_UKV + (size_t)pn * 256 * 128, 128, acc, lds);
        const float* RKV = (const float*)(p.ws + OFF_RKV);
        bf16_t* KM = (bf16_t*)(p.ws + OFF_KM); bf16_t* VTM = (bf16_t*)(p.ws + OFF_VTM);
        const int head = pn * 2 + wc;
#pragma unroll
        for (int mi = 0; mi < 2; ++mi) {
            const int mb = pm * 128 + wr * 64 + mi * 32 + 4 * h;
            float rs[16];
#pragma unroll
            for (int reg = 0; reg < 16; ++reg) rs[reg] = RKV[mb + (reg & 3) + 8 * (reg >> 2)];
#pragma unroll
            for (int ni = 0; ni < 2; ++ni) {
#pragma unroll
                for (int reg = 0; reg < 16; ++reg)
                    KM[((size_t)(mb + (reg & 3) + 8 * (reg >> 2)) * 8 + head) * 96 + ni * 32 + r] = (bf16_t)(pk2(acc[mi][ni][reg] * rs[reg], 0.f) & 0xffff);
            }
#pragma unroll
            for (int ni = 2; ni < 4; ++ni) {
#pragma unroll
                for (int g = 0; g < 4; ++g) {
                    u32x2 w = {pk2(acc[mi][ni][4 * g] * rs[4 * g], acc[mi][ni][4 * g + 1] * rs[4 * g + 1]), pk2(acc[mi][ni][4 * g + 2] * rs[4 * g + 2], acc[mi][ni][4 * g + 3] * rs[4 * g + 3])};
                    *(u32x2*)(VTM + (size_t)(head * 64 + (ni - 2) * 32 + r) * TH + mb + 8 * g) = w;
                }
            }
        }
    }
}

template <int D>
__device__ __forceinline__ void attn_item(const bf16_t* Q, int qs, const bf16_t* Kp, int kst, const bf16_t* Vt, bf16_t* O, int os, const float* ck, const unsigned* nrm, int qb, unsigned char* lds) {
    constexpr int KLD = D + 8, NKP = D / 32, KPR = D / 8;
    bf16_t* Ks = (bf16_t*)lds; bf16_t* Vs = Ks + 2 * 64 * KLD; float* cks = (float*)(Vs + 2 * 64 * 72);
    const int tid = tidx(), lane = tid & 63, wave = tid >> 6, r = lane & 31, h = lane >> 5;
    const int q0 = qb * 128, qw0 = q0 + 32 * wave;
    bf16x8 qf[D / 16];
#pragma unroll
    for (int ks = 0; ks < D / 16; ++ks) qf[ks] = *(const bf16x8*)(Q + (size_t)(qw0 + r) * qs + ks * 16 + h * 8);
    const int nkt = (q0 + 128) / 64;
    u32x4 rk[2][NKP], rv[2][2]; float rck[2] = {0.f, 0.f};
    float coff = 0.f; bool fx = false;
    if (ck) {
        const float beff = 1.01f * sqrtf(__uint_as_float(nrm[0]) * __uint_as_float(nrm[8])) + 1.f;
        const float cref = ck[q0 + 127];
        fx = (2.f * beff + (ck[q0] - cref)) < 100.f;
        if (fx) coff = cref - beff;
    }
    auto gload = [&](int st, int kt) {
        const int k0 = kt * 64;
#pragma unroll
        for (int i = 0; i < NKP; ++i) { const int id = tid + 256 * i, row = id / KPR, c = id % KPR; rk[st][i] = *(const u32x4*)(Kp + (size_t)(k0 + row) * kst + c * 8); }
#pragma unroll
        for (int i = 0; i < 2; ++i) { const int id = tid + 256 * i, row = id >> 3, c = id & 7; rv[st][i] = *(const u32x4*)(Vt + (size_t)row * TH + k0 + c * 8); }
        if (ck && tid < 64) rck[st] = ck[k0 + tid];
    };
    auto lstore = [&](int st, int buf) {
#pragma unroll
        for (int i = 0; i < NKP; ++i) { const int id = tid + 256 * i, row = id / KPR, c = id % KPR; *(u32x4*)(Ks + buf * 64 * KLD + row * KLD + c * 8) = rk[st][i]; }
#pragma unroll
        for (int i = 0; i < 2; ++i) { const int id = tid + 256 * i, row = id >> 3, c = id & 7; *(u32x4*)(Vs + buf * 64 * 72 + row * 72 + c * 8) = rv[st][i]; }
        if (ck && tid < 64) cks[buf * 64 + tid] = coff - rck[st];
    };
    f32x16 ot[2];
#pragma unroll
    for (int e = 0; e < 16; ++e) { ot[0][e] = 0.f; ot[1][e] = 0.f; }
    float mrun = -INFINITY, lsum = 0.f;
    auto tile = [&](int kt, int cur) {
        const int k0 = kt * 64;
        if (k0 <= qw0 + 31) {
            const bf16_t* Kc = Ks + cur * 64 * KLD + r * KLD + h * 8;
            const float* ckc = cks + cur * 64;
            f32x16 st[2];
            const float moff = (!ck && kt > 0) ? mrun : 0.f;
#pragma unroll
            for (int mt = 0; mt < 2; ++mt)
#pragma unroll
                for (int g = 0; g < 4; ++g) {
                    if (ck) {
                        const f32x4 c4 = *(const f32x4*)(ckc + 32 * mt + 8 * g + 4 * h);
#pragma unroll
                        for (int e = 0; e < 4; ++e) st[mt][4 * g + e] = c4[e];
                    } else {
#pragma unroll
                        for (int e = 0; e < 4; ++e) st[mt][4 * g + e] = -moff;
                    }
                }
            {
                bf16x8 kfr[2][2];
                kfr[0][0] = *(const bf16x8*)(Kc); kfr[0][1] = *(const bf16x8*)(Kc + 32 * KLD);
#pragma unroll
                for (int ks = 0; ks < D / 16; ++ks) {
                    const int cb = ks & 1, nb = cb ^ 1;
                    if (ks + 1 < D / 16) { kfr[nb][0] = *(const bf16x8*)(Kc + (ks + 1) * 16); kfr[nb][1] = *(const bf16x8*)(Kc + 32 * KLD + (ks + 1) * 16); }
                    __builtin_amdgcn_sched_barrier(0);
                    st[0] = mfma32(kfr[cb][0], qf[ks], st[0]); st[1] = mfma32(kfr[cb][1], qf[ks], st[1]);
                    __builtin_amdgcn_sched_barrier(0);
                }
            }
            if (k0 + 63 > qw0) {
#pragma unroll
                for (int mt = 0; mt < 2; ++mt)
#pragma unroll
                    for (int e = 0; e < 16; ++e) {
                        const int key = 32 * mt + (e & 3) + 8 * (e >> 2) + 4 * h;
                        if (k0 + key > qw0 + r) st[mt][e] = -INFINITY;
                    }
            }
            float sub = 0.f; bool needsub = false;
            if (!(ck && fx)) {
                float mloc = -INFINITY;
#pragma unroll
                for (int e = 0; e < 16; ++e) mloc = max3f(mloc, st[0][e], st[1][e]);
                { float a, c; halves32(mloc, a, c); mloc = fmaxf(a, c); }
                float alpha;
                if (ck) {
                    const float mnew = fmaxf(mrun, mloc);
                    alpha = ex2(mrun - mnew);
                    mrun = mnew; sub = mnew; needsub = true;
                } else {
                    const float d = (kt == 0) ? mloc : fmaxf(mloc, 0.f);
                    alpha = (kt == 0) ? 0.f : ex2(-d);
                    mrun = moff + d;
                    if (__builtin_amdgcn_ballot_w64(d != 0.f) != 0ull) { sub = d; needsub = true; }
                }
                lsum *= alpha;
                if (__builtin_amdgcn_ballot_w64(alpha != 1.f) != 0ull) {
#pragma unroll
                    for (int e = 0; e < 16; ++e) { ot[0][e] *= alpha; ot[1][e] *= alpha; }
                }
            }
            const bf16_t* Vc = Vs + cur * 64 * 72 + r * 72 + 4 * h;
            if (needsub) {
#pragma unroll
                for (int e = 0; e < 16; ++e) { st[0][e] -= sub; st[1][e] -= sub; }
            }
            {
                u32x2 vfr[2][2][2];
                float psum = 0.f;
#pragma unroll
                for (int dt = 0; dt < 2; ++dt) { vfr[0][dt][0] = *(const u32x2*)(Vc + dt * 32 * 72); vfr[0][dt][1] = *(const u32x2*)(Vc + dt * 32 * 72 + 8); }
#pragma unroll
                for (int stp = 0; stp < 4; ++stp) {
                    const int mt = stp >> 1, s2 = stp & 1, cb = stp & 1, nb = cb ^ 1;
                    if (stp < 3) {
                        const int mtn = (stp + 1) >> 1, s2n = (stp + 1) & 1;
#pragma unroll
                        for (int dt = 0; dt < 2; ++dt) {
                            vfr[nb][dt][0] = *(const u32x2*)(Vc + dt * 32 * 72 + 32 * mtn + 16 * s2n);
                            vfr[nb][dt][1] = *(const u32x2*)(Vc + dt * 32 * 72 + 32 * mtn + 16 * s2n + 8);
                        }
                    }
                    float pe[8];
#pragma unroll
                    for (int e = 0; e < 8; ++e) pe[e] = ex2(st[mt][8 * s2 + e]);
                    psum += ((pe[0] + pe[1]) + (pe[2] + pe[3])) + ((pe[4] + pe[5]) + (pe[6] + pe[7]));
                    const bf16x8 pf = mk8(pk2(pe[0], pe[1]), pk2(pe[2], pe[3]), pk2(pe[4], pe[5]), pk2(pe[6], pe[7]));
                    __builtin_amdgcn_sched_barrier(0);
#pragma unroll
                    for (int dt = 0; dt < 2; ++dt)
                        ot[dt] = mfma32(mk8(vfr[cb][dt][0].x, vfr[cb][dt][0].y, vfr[cb][dt][1].x, vfr[cb][dt][1].y), pf, ot[dt]);
                    __builtin_amdgcn_sched_barrier(0);
                }
                lsum += psum;
            }
        }
        if (kt + 1 < nkt) {
            lstore(cur ^ 1, cur ^ 1);
            if (kt + 3 < nkt) gload(cur ^ 1, kt + 3);
        }
        lds_barrier();
    };
    int kts = 0;
    if (ck) {
        int* s4 = (int*)(lds + LDS_BYTES - 64);
        const float bnd = sqrtf(__uint_as_float(nrm[0]) * __uint_as_float(nrm[8]));
        const float thr = -(162.f + 2.02f * bnd);
        bool keep = true;
        if (tid < nkt) keep = (ck[q0] - ck[64 * tid + 63]) >= thr;
        const unsigned long long bal = __builtin_amdgcn_ballot_w64(keep);
        if (lane == 0) s4[wave] = 64 * wave + (bal ? (int)__builtin_ctzll(bal) : 64);
    }
    __syncthreads();
    if (ck) {
        const int* s4 = (const int*)(lds + LDS_BYTES - 64);
        kts = min(min(s4[0], s4[1]), min(s4[2], s4[3]));
        kts = min(kts, nkt - 2) & ~1;
    }
    gload(0, kts);
    gload(1, kts + 1);
    lstore(0, 0);
    if (kts + 2 < nkt) gload(0, kts + 2);
    lds_barrier();
#pragma unroll 1
    for (int kt = kts; kt < nkt; kt += 2) { tile(kt, 0); tile(kt + 1, 1); }
    const float l = lsum + __shfl_xor(lsum, 32);
    const float inv = 1.f / l;
#pragma unroll
    for (int dt = 0; dt < 2; ++dt)
#pragma unroll
        for (int g = 0; g < 4; ++g) {
            u32x2 w = {pk2(ot[dt][4 * g] * inv, ot[dt][4 * g + 1] * inv), pk2(ot[dt][4 * g + 2] * inv, ot[dt][4 * g + 3] * inv)};
            *(u32x2*)(O + (size_t)(qw0 + r) * os + 32 * dt + 8 * g + 4 * h) = w;
        }
}

__device__ __forceinline__ void phase_attn(const Params& p, int l, int b, unsigned char* lds, int dup) {
    int* ctr = (int*)(p.ws + OFF_CTRL) + 32 + (l * 2 + b) * 8 + (dup ? 64 : 0);
    bf16_t* dry = (bf16_t*)(p.ws + WS_END);
    int* s_item = (int*)(lds + LDS_BYTES - 16);
    bf16_t* PB = (bf16_t*)(p.ws + OFF_PB);
    const int myq = (int)(xb_xcc_id() & 7u);
    unsigned* dn2flag = (unsigned*)(p.ws + OFF_CTRL) + 16 + (l * 2 + b);
    bool dn2_seen = false;
    if (!dup && blockIdx.x < 8) {
        dn2_block(p, blockIdx.x, lds);
        asm volatile("s_waitcnt vmcnt(0)" ::: "memory");
        __syncthreads();
        if (threadIdx.x == 0) {
            __builtin_amdgcn_fence(__ATOMIC_RELEASE, "agent");
            asm volatile("s_waitcnt vmcnt(0)" ::: "memory");
            (void)xb_add(dn2flag, 1u);
        }
    }
    for (;;) {
        __syncthreads();
        if (tidx() == 0) {
            int found = -1;
            for (int sq = 0; sq < 8; ++sq) {
                const int q = (myq + sq) & 7;
                const int it = atomicAdd(&ctr[q], 1);
                if (it < 512) { found = q * 512 + it; break; }
            }
            *s_item = found;
        }
        __syncthreads();
        const int enc = *s_item;
        if (enc < 0) break;
        const int hd = enc >> 9, it = enc & 511;
        if (it >= 256 && !dup && !dn2_seen) {
            if (threadIdx.x == 0) {
                while (xb_ld(dn2flag) < 8u) __builtin_amdgcn_s_sleep(8);
                __builtin_amdgcn_fence(__ATOMIC_ACQUIRE, "agent");
                asm volatile("s_waitcnt vmcnt(0)" ::: "memory");
            }
            __syncthreads();
            dn2_seen = true;
        }
        if (it < 256) {
            const int qb = 127 - (it >> 1), kind = it & 1;
            if (kind == 0) {
                attn_item<64>(PB + hd * 64, PBW, PB + 512 + hd * 64, PBW, (const bf16_t*)(p.ws + OFF_VTF) + (size_t)hd * 64 * TH,
                              dup ? dry + hd * 64 : PB + hd * 64, dup ? 1024 : PBW, (const float*)(p.ws + OFF_CF) + (size_t)hd * TH,
                              (const unsigned*)(p.ws + OFF_CTRL) + 160 + (l * 2 + b) * 16 + hd, qb, lds);
            } else {
                bf16_t* QF = (bf16_t*)(p.ws + OFF_QF);
                attn_item<96>(QF + hd * 96, 768, (const bf16_t*)(p.ws + OFF_KM) + hd * 96, 768, (const bf16_t*)(p.ws + OFF_VTM) + (size_t)hd * 64 * TH,
                              dup ? dry + 512 + hd * 64 : QF + hd * 96, dup ? 1024 : 768, nullptr, nullptr, qb, lds);
            }
        } else {
            if (!dup) dn3_item(p, l, (it - 256) * 8 + hd, lds);
        }
    }
}

__device__ __forceinline__ void phase_gate(const Params& p, int l, int b, unsigned char* lds) {
    const bf16_t* hb = (const bf16_t*)(p.ws + OFF_HB) + (size_t)b * TH * DM;
    const bf16_t* wg = (const bf16_t*)(p.ws + OFF_WB) + W_G;
    bf16_t* G = (bf16_t*)(p.ws + OFF_G);
    const float* bg = p.b_gate + (size_t)l * 3072;
    const int lane = tidx() & 63, wave = tidx() >> 6, wr = wave >> 1, wc = wave & 1, r = lane & 31, h = lane >> 5;
    int pm, pn;
#pragma unroll 1
    for (int k = 0; tile_at(k, TH / 128, 12, pm, pn); ++k) {
        f32x16 acc[2][4]; ZERO_ACC4(acc);
        gemm_big(hb + (size_t)pm * 128 * DM, DM, wg + (size_t)pn * 256 * DM, DM, acc, lds);
#pragma unroll
        for (int ni = 0; ni < 4; ++ni) {
            const int n = pn * 256 + wc * 128 + ni * 32 + r;
            const float bias = bg[n];
#pragma unroll
            for (int mi = 0; mi < 2; ++mi)
#pragma unroll
                for (int reg = 0; reg < 16; ++reg) {
                    const int m = pm * 128 + wr * 64 + mi * 32 + (reg & 3) + 8 * (reg >> 2) + 4 * h;
                    G[(size_t)m * 3072 + n] = (bf16_t)(pk2(sigmf(acc[mi][ni][reg] + bias), 0.f) & 0xffff);
                }
        }
    }
}
__device__ __forceinline__ void phase_mix(const Params& p, int l, int b, unsigned char* lds) {
    const bf16_t* wb = (const bf16_t*)(p.ws + OFF_WB);
    const bf16_t* PB = (const bf16_t*)(p.ws + OFF_PB);
    const bf16_t* QF = (const bf16_t*)(p.ws + OFF_QF);
    const bf16_t* G = (const bf16_t*)(p.ws + OFF_G);
    bf16_t* MIX = (bf16_t*)(p.ws + OFF_MIX);
    const int lane = tidx() & 63, wave = tidx() >> 6, wr = wave >> 1, wc = wave & 1, r = lane & 31, h = lane >> 5;
    int pm, pn;
#pragma unroll 1
    for (int k = 0; tile_at(k, TH / 128, 8, pm, pn); ++k) {
        f32x16 mix[2][2]; ZERO_ACC(mix);
#pragma unroll 1
        for (int br = 0; br < 3; ++br) {
            f32x16 acc[2][2]; ZERO_ACC(acc);
            const bf16_t* A; long lda; int acs; const bf16_t* W;
            if (br == 0) { A = PB + (size_t)pm * 128 * PBW; lda = PBW; acs = 64; W = wb + W_BRF; }
            else if (br == 1) { A = QF + (size_t)pm * 128 * 768; lda = 768; acs = 96; W = wb + W_BRM; }
            else { A = PB + (size_t)pm * 128 * PBW + PB_DN; lda = PBW; acs = 64; W = wb + W_BRD; }
            gemm_core<2>(A, lda, acs, W + (size_t)pn * 128 * 512, 512, acc, lds);
#pragma unroll
            for (int mi = 0; mi < 2; ++mi)
#pragma unroll
                for (int ni = 0; ni < 2; ++ni) {
                    const bf16_t* gp = G + (size_t)(pm * 128 + wr * 64 + mi * 32 + 4 * h) * 3072 + br * 1024 + pn * 128 + wc * 64 + ni * 32 + r;
#pragma unroll
                    for (int reg = 0; reg < 16; ++reg) {
                        const float g = bflo((uint32_t)gp[(size_t)((reg & 3) + 8 * (reg >> 2)) * 3072]);
                        mix[mi][ni][reg] += g * acc[mi][ni][reg];
                    }
                }
        }
#pragma unroll
        for (int mi = 0; mi < 2; ++mi)
#pragma unroll
            for (int ni = 0; ni < 2; ++ni)
#pragma unroll
                for (int reg = 0; reg < 16; ++reg) {
                    const int m = pm * 128 + wr * 64 + mi * 32 + (reg & 3) + 8 * (reg >> 2) + 4 * h;
                    const int n = pn * 128 + wc * 64 + ni * 32 + r;
                    MIX[(size_t)m * DM + n] = (bf16_t)(pk2(mix[mi][ni][reg], 0.f) & 0xffff);
                }
    }
}

__device__ __forceinline__ void phase_prologue(const Params& p) {
    const size_t gt = (size_t)blockIdx.x * 256 + tidx(), gs = (size_t)gridDim.x * 256;
    const f32x4* xs = (const f32x4*)p.x; f32x4* xo = (f32x4*)p.out;
    for (size_t i = gt; i < (size_t)TOK * DM / 4; i += gs) xo[i] = xs[i];
    float* rope = (float*)(p.ws + OFF_ROPE);
    for (size_t i = gt; i < (size_t)TOK * 16; i += gs) {
        const int t = (int)(i >> 4), j = (int)(i & 15);
        const float inv = ex2(-(float)j * 0.8304820237218406f);
        const float ang = (float)p.pos[t] * inv;
        const double a = (double)ang;
        const double kk = __builtin_rint(a * 0.15915494309189535);
        const float rr = (float)__builtin_fma(-kk, 6.283185307179586, a);
        rope[(size_t)t * 32 + j] = __cosf(rr);
        rope[(size_t)t * 32 + 16 + j] = __sinf(rr);
    }
    if (blockIdx.x == 0 && tidx() < 64) ((int*)(p.ws + OFF_CTRL))[tidx()] = 0;
}

enum { K_PRO = 0, K_FINAL, K_S0, K_GU1, K_DOWN1, K_NORMMIX, K_WIN, K_MID, K_UP, K_ATTN, K_GATE, K_MIX, K_WOUT, K_NORM2, K_GU2, K_DOWN2, K_COUNT };
__host__ __device__ __forceinline__ int kind_of(int ph, int& l, int& b) {
    l = 0; b = 0;
    if (ph == 0) return K_PRO;
    if (ph == NPHASE - 1) return K_FINAL;
    l = (ph - 1) / 21; const int sp = (ph - 1) % 21;
    if (sp == 0) return K_S0;
    if (sp == 1) return K_GU1;
    if (sp == 2) return K_DOWN1;
    if (sp == 3) return K_NORMMIX;
    if (sp == 18) return K_NORM2;
    if (sp == 19) return K_GU2;
    if (sp == 20) return K_DOWN2;
    b = (sp - 4) / 7;
    return K_WIN + (sp - 4) % 7;
}
template <int KIND>
__device__ __forceinline__ void run_kind(const Params& p0, int l, int b, unsigned char* lds, int dup = 0) {
    Params p = p0;
    size_t zoff = 0;
    asm volatile("" : "+s"(zoff));
    p.ws = p0.ws + zoff; p.out = p0.out + zoff;
    const bf16_t* wb = (const bf16_t*)(p.ws + OFF_WB);
    bf16_t* hb = (bf16_t*)(p.ws + OFF_HB);
    const bf16_t* act = (const bf16_t*)(p.ws + OFF_BIG);
    if constexpr (KIND == K_PRO) { phase_prologue(p); phase_wconv(p, 0, lds); phase_rmsnorm(p.x, p.ffn1_norm, hb, nullptr); }
    else if constexpr (KIND == K_FINAL) { phase_rmsnorm(p.out, p.final_norm, nullptr, p.out); }
    else if constexpr (KIND == K_S0) { phase_wconv(p, l, lds); phase_rmsnorm(p.out, p.ffn1_norm + l * DM, hb, nullptr); }
    else if constexpr (KIND == K_GU1) { phase_gu(p, wb + W_GU1, lds); }
    else if constexpr (KIND == K_DOWN1) { phase_resid(p, act, DFF, TOK, wb + W_DN1, DFF, p.out, dup ? 0.f : 0.5f, lds); }
    else if constexpr (KIND == K_NORMMIX) { phase_rmsnorm(p.out, p.mix_norm + l * DM, hb, nullptr); }
    else if constexpr (KIND == K_NORM2) { phase_rmsnorm(p.out, p.ffn2_norm + l * DM, hb, nullptr); }
    else if constexpr (KIND == K_GU2) { phase_gu(p, wb + W_GU2, lds); }
    else if constexpr (KIND == K_DOWN2) { phase_resid(p, act, DFF, TOK, wb + W_DN2, DFF, p.out, dup ? 0.f : 0.5f, lds); }
    else if constexpr (KIND == K_WIN) { phase_win(p, b, lds); }
    else if constexpr (KIND == K_MID) {
        constexpr int NI = 8 + 256 + 2048;
        int* qctr = (int*)(p.ws + OFF_CTRL) + 448 + (l * 2 + b) + (dup ? 8 : 0);
        int* s_it = (int*)(lds + LDS_BYTES - 16);
        for (;;) {
            __syncthreads();
            if (tidx() == 0) *s_it = atomicAdd(qctr, 1);
            __syncthreads();
            const int it = *s_it;
            if (it >= NI) break;
            if (it < 8) fox_cumsum_item(p, l, it, lds);
            else if (it < 8 + 256) mla_rows_item(p, b, it - 8, (unsigned*)(p.ws + OFF_CTRL) + 160 + (l * 2 + b) * 16);
            else dn1_item(p, l, it - 8 - 256, lds);
        }
    }
    else if constexpr (KIND == K_UP) {
#pragma unroll 1
        for (int it = blockIdx.x; it < 384 + 512; it += gridDim.x) mla_up_tile(p, b, it, lds);
    }
    else if constexpr (KIND == K_ATTN) { phase_attn(p, l, b, lds, dup); }
    else if constexpr (KIND == K_GATE) { phase_gate(p, l, b, lds); }
    else if constexpr (KIND == K_MIX) { phase_mix(p, l, b, lds); }
    else if constexpr (KIND == K_WOUT) { phase_resid(p, (const bf16_t*)(p.ws + OFF_MIX), DM, TH, wb + W_OUT, DM, p.out + (size_t)b * TH * DM, dup ? 0.f : 1.0f, lds); }
}

template <int KIND>
__global__ void __launch_bounds__(256, 2) phase_k(Params p, int l, int b) {
    extern __shared__ __attribute__((aligned(16))) unsigned char lds[];
    run_kind<KIND>(p, l, b, lds);
}

__device__ __forceinline__ void run_any(const Params& p, int kind, int l, int b, unsigned char* lds, int dup) {
    switch (kind) {
    case K_PRO: run_kind<K_PRO>(p, l, b, lds, dup); break;
    case K_FINAL: run_kind<K_FINAL>(p, l, b, lds, dup); break;
    case K_S0: run_kind<K_S0>(p, l, b, lds, dup); break;
    case K_GU1: run_kind<K_GU1>(p, l, b, lds, dup); break;
    case K_DOWN1: run_kind<K_DOWN1>(p, l, b, lds, dup); break;
    case K_NORMMIX: run_kind<K_NORMMIX>(p, l, b, lds, dup); break;
    case K_WIN: run_kind<K_WIN>(p, l, b, lds, dup); break;
    case K_MID: run_kind<K_MID>(p, l, b, lds, dup); break;
    case K_UP: run_kind<K_UP>(p, l, b, lds, dup); break;
    case K_ATTN: run_kind<K_ATTN>(p, l, b, lds, dup); break;
    case K_GATE: run_kind<K_GATE>(p, l, b, lds, dup); break;
    case K_MIX: run_kind<K_MIX>(p, l, b, lds, dup); break;
    case K_WOUT: run_kind<K_WOUT>(p, l, b, lds, dup); break;
    case K_NORM2: run_kind<K_NORM2>(p, l, b, lds, dup); break;
    case K_GU2: run_kind<K_GU2>(p, l, b, lds, dup); break;
    default: run_kind<K_DOWN2>(p, l, b, lds, dup); break;
    }
}
#if ONE_LAUNCH
__global__ void __launch_bounds__(256, 2) mega(Params p, int ph_lo, int ph_hi) {
    extern __shared__ __attribute__((aligned(16))) unsigned char lds[];
    volatile LAS unsigned* xst = (volatile LAS unsigned*)(lds + LDS_BYTES - 32);
    if (threadIdx.x == 0) { xst[0] = 0u; xst[1] = 0u; }
    __syncthreads();
    const XcdBarrier xb = xcd_barrier_post((unsigned*)(p.ws + OFF_CTRL) + 1024, xst);
    for (int ph = ph_lo; ph < ph_hi; ++ph) {
        int l, b; const int kind = kind_of(ph, l, b);
#if PROBE_DUP
        {
            int cat = 32;
            if (kind == K_GU1 || kind == K_DOWN1 || kind == K_GU2 || kind == K_DOWN2) cat = 1;
            else if (kind == K_WIN || kind == K_GATE || kind == K_MIX || kind == K_WOUT) cat = 2;
            else if (kind == K_ATTN) cat = 4;
            else if (kind == K_MID) cat = 8;
            else if (kind == K_UP) cat = 16;
            else if (kind == K_FINAL) cat = 0;
            if (cat & PROBE_DUP) { run_any(p, kind, l, b, lds, 1); xcd_barrier(xb); }
        }
#endif
        if (kind == K_S0 && l == 0) continue;
        run_any(p, kind, l, b, lds, 0);
        if (ph + 1 < ph_hi) {
            if (ph == ph_lo) cg::this_grid().sync();
            else xcd_barrier(xb);
#if (PROBE_DUP & 64)
            xcd_barrier(xb);
#endif
        }
    }
}
#endif

template <int KIND>
static void launch_kind(const Params& p, int l, int b, int grid, hipStream_t stream) {
    static bool attr = false;
    if (!attr) { (void)hipFuncSetAttribute((const void*)phase_k<KIND>, hipFuncAttributeMaxDynamicSharedMemorySize, LDS_BYTES); attr = true; }
    hipLaunchKernelGGL(phase_k<KIND>, dim3(grid), dim3(256), LDS_BYTES, stream, p, l, b);
}

extern "C" void kernel_launch(void* const* d_in, const int* in_sizes, int n_in, void* d_out, int out_size, void* d_ws, size_t ws_size, hipStream_t stream) {
    static int grid = 0;
    if (grid == 0) {
        if (ws_size < WS_END) { fprintf(stderr, "kernel_launch: workspace too small: %zu < %zu\n", ws_size, (size_t)WS_END); grid = -1; return; }
        int dev = 0, cus = 0, per_cu = 0;
        (void)hipGetDevice(&dev);
        (void)hipDeviceGetAttribute(&cus, hipDeviceAttributeMultiprocessorCount, dev);
#if ONE_LAUNCH
        (void)hipFuncSetAttribute((const void*)mega, hipFuncAttributeMaxDynamicSharedMemorySize, LDS_BYTES);
        (void)hipOccupancyMaxActiveBlocksPerMultiprocessor(&per_cu, (const void*)mega, 256, LDS_BYTES);
#else
        per_cu = 2;
#endif
        if (per_cu < 1) per_cu = 1;
        if (per_cu > 2) per_cu = 2;
        grid = cus * per_cu;
        (void)hipGetLastError();
    }
    if (grid < 0) return;
    Params p{};
    p.x = (const float*)d_in[0]; p.pos = (const int*)d_in[1];
    p.ffn1_norm = (const float*)d_in[2]; p.ffn1_gu = (const float*)d_in[3]; p.ffn1_down = (const float*)d_in[4];
    p.mix_norm = (const float*)d_in[5]; p.w_in = (const float*)d_in[6]; p.b_gate = (const float*)d_in[7]; p.fox_bf = (const float*)d_in[8];
    p.mla_qn = (const float*)d_in[9]; p.mla_uq = (const float*)d_in[10]; p.mla_kvn = (const float*)d_in[11]; p.mla_ukv = (const float*)d_in[12];
    p.dn_conv = (const float*)d_in[13]; p.dn_alog = (const float*)d_in[14]; p.dn_dtb = (const float*)d_in[15]; p.dn_onorm = (const float*)d_in[16];
    p.br_fox = (const float*)d_in[17]; p.br_mla = (const float*)d_in[18]; p.br_dn = (const float*)d_in[19]; p.w_out = (const float*)d_in[20];
    p.ffn2_norm = (const float*)d_in[21]; p.ffn2_gu = (const float*)d_in[22]; p.ffn2_down = (const float*)d_in[23]; p.final_norm = (const float*)d_in[24];
    p.out = (float*)d_out; p.ws = (unsigned char*)d_ws;
#if ONE_LAUNCH
    (void)hipMemsetAsync((unsigned char*)d_ws + OFF_CTRL, 0, 32768, stream);
    int lo = 0, hi = NPHASE;
    void* args[] = {&p, &lo, &hi};
    hipError_t e = hipLaunchCooperativeKernel((const void*)mega, dim3(grid), dim3(256), args, LDS_BYTES, stream);
    if (e != hipSuccess) fprintf(stderr, "cooperative launch failed: %s (grid %d)\n", hipGetErrorString(e), grid);
#else
    for (int ph = 0; ph < NPHASE; ++ph) {
        int l, b; const int kind = kind_of(ph, l, b);
        switch (kind) {
        case K_PRO: launch_kind<K_PRO>(p, l, b, grid, stream); break;
        case K_FINAL: launch_kind<K_FINAL>(p, l, b, grid, stream); break;
        case K_S0: launch_kind<K_S0>(p, l, b, grid, stream); break;
        case K_GU1: launch_kind<K_GU1>(p, l, b, grid, stream); break;
        case K_DOWN1: launch_kind<K_DOWN1>(p, l, b, grid, stream); break;
        case K_NORMMIX: launch_kind<K_NORMMIX>(p, l, b, grid, stream); break;
        case K_WIN: launch_kind<K_WIN>(p, l, b, grid, stream); break;
        case K_MID: launch_kind<K_MID>(p, l, b, grid, stream); break;
        case K_UP: launch_kind<K_UP>(p, l, b, grid, stream); break;
        case K_ATTN: launch_kind<K_ATTN>(p, l, b, grid, stream); break;
        case K_GATE: launch_kind<K_GATE>(p, l, b, grid, stream); break;
        case K_MIX: launch_kind<K_MIX>(p, l, b, grid, stream); break;
        case K_WOUT: launch_kind<K_WOUT>(p, l, b, grid, stream); break;
        case K_NORM2: launch_kind<K_NORM2>(p, l, b, grid, stream); break;
        case K_GU2: launch_kind<K_GU2>(p, l, b, grid, stream); break;
        default: launch_kind<K_DOWN2>(p, l, b, grid, stream); break;
        }
    }
#endif
}
```

```cpp
#include <hip/hip_runtime.h>
#include <hip/hip_cooperative_groups.h>
#include <stdint.h>
#include <cstdio>
#include <type_traits>
namespace cg = cooperative_groups;

#ifndef PROBE_DUP
#define PROBE_DUP 0
#endif
#ifndef ONE_LAUNCH
#define ONE_LAUNCH 1
#endif

typedef unsigned short bf16_t;
typedef short bf16x8 __attribute__((ext_vector_type(8)));
typedef float f32x16 __attribute__((ext_vector_type(16)));
typedef float f32x4 __attribute__((ext_vector_type(4)));
typedef unsigned int u32x4 __attribute__((ext_vector_type(4)));
typedef unsigned int u32x2 __attribute__((ext_vector_type(2)));
typedef float f32x2 __attribute__((ext_vector_type(2)));

constexpr int TOK = 32768, TH = 16384, DM = 1024, DFF = 2816, NLAYER = 4, NIN = 7096;
constexpr int PBW = 3968;
constexpr int PB_CQ = 1536, PB_CKV = 1792, PB_DN = 1920;
constexpr float EPS = 1e-6f;
constexpr float LOG2E = 1.4426950408889634f;
constexpr int LDS_BYTES = 77824;
constexpr int NPHASE = 2 + 21 * NLAYER;

constexpr size_t OFF_CTRL = 0;
constexpr size_t OFF_ROPE = 32768;
constexpr size_t OFF_WB   = OFF_ROPE + (size_t)TOK * 32 * 4;
constexpr size_t W_GU1 = 0;
constexpr size_t W_DN1 = W_GU1 + (size_t)5632 * 1024;
constexpr size_t W_IN  = W_DN1 + (size_t)1024 * 2816;
constexpr size_t W_G   = W_IN + (size_t)4096 * 1024;
constexpr size_t W_UQ  = W_G + (size_t)3072 * 1024;
constexpr size_t W_UKV = W_UQ + (size_t)768 * 256;
constexpr size_t W_BRF = W_UKV + (size_t)1024 * 128;
constexpr size_t W_BRM = W_BRF + (size_t)1024 * 512;
constexpr size_t W_BRD = W_BRM + (size_t)1024 * 512;
constexpr size_t W_OUT = W_BRD + (size_t)1024 * 512;
constexpr size_t W_GU2 = W_OUT + (size_t)1024 * 1024;
constexpr size_t W_DN2 = W_GU2 + (size_t)5632 * 1024;
constexpr size_t W_END = W_DN2 + (size_t)1024 * 2816;
constexpr size_t OFF_HB  = OFF_WB + W_END * 2;
constexpr size_t OFF_BIG = OFF_HB + (size_t)TOK * DM * 2;
constexpr size_t OFF_PB  = OFF_BIG;
constexpr size_t OFF_S32 = OFF_PB + (size_t)TH * PBW * 2;
constexpr size_t OFF_VTF = OFF_S32 + (size_t)TH * 64 * 4;
constexpr size_t OFF_QF  = OFF_VTF + (size_t)512 * TH * 2;
constexpr size_t OFF_KM  = OFF_QF + (size_t)TH * 768 * 2;
constexpr size_t OFF_VTM = OFF_KM + (size_t)TH * 768 * 2;
constexpr size_t OFF_CF  = OFF_VTM + (size_t)512 * TH * 2;
constexpr size_t OFF_RQ  = OFF_CF + (size_t)8 * TH * 4;
constexpr size_t OFF_RKV = OFF_RQ + (size_t)TH * 4;
constexpr size_t OFF_DNA = OFF_RKV + (size_t)TH * 4;
constexpr size_t DN_SZ   = (size_t)2048 * 4096 * 4;
constexpr size_t OFF_DNB = OFF_DNA + DN_SZ;
constexpr size_t OFF_DNS = OFF_DNB + DN_SZ;
constexpr size_t OFF_DNQ = OFF_DNS + DN_SZ;
constexpr size_t OFF_DNO = OFF_DNQ + DN_SZ;
constexpr size_t OFF_MIX = OFF_DNA;
constexpr size_t OFF_G   = OFF_DNB;
constexpr size_t WS_END  = OFF_DNO + DN_SZ;
static_assert(WS_END >= OFF_BIG + (size_t)TOK * DFF * 2, "act fits");

struct Params {
    const float* x; const int* pos;
    const float *ffn1_norm, *ffn1_gu, *ffn1_down, *mix_norm, *w_in, *b_gate, *fox_bf, *mla_qn, *mla_uq, *mla_kvn, *mla_ukv,
        *dn_conv, *dn_alog, *dn_dtb, *dn_onorm, *br_fox, *br_mla, *br_dn, *w_out, *ffn2_norm, *ffn2_gu, *ffn2_down, *final_norm;
    float* out; unsigned char* ws;
};

__device__ __forceinline__ int tidx() { int t = threadIdx.x; asm volatile("" : "+v"(t)); return t; }
__device__ __forceinline__ void lds_barrier() { asm volatile("s_waitcnt lgkmcnt(0)\n\ts_barrier" ::: "memory"); }
#define XB_TMO      128
#define XB_XCNT(j)  (256  + 64 * (j))
#define XB_XSUB(j)  (1280 + 64 * (j))
#define XB_XGEN(j)  (2304 + 64 * (j))
#define XB_TOP      3328
#define XB_TOPGEN   3392
#define XCD_BAR_WORDS 3456
#define XB_SPIN_CAP (1u << 22)
#define LAS __attribute__((address_space(3)))
__device__ __forceinline__ unsigned xb_ld(unsigned* p)              { return __hip_atomic_load(p, __ATOMIC_RELAXED, __HIP_MEMORY_SCOPE_AGENT); }
__device__ __forceinline__ unsigned xb_add(unsigned* p, unsigned v) { return __hip_atomic_fetch_add(p, v, __ATOMIC_RELAXED, __HIP_MEMORY_SCOPE_AGENT); }
__device__ __forceinline__ unsigned xb_xcc_id() { return (unsigned)__builtin_amdgcn_s_getreg((3 << 11) | 20) & 0xFu; }
#define XB_SPIN(cond, bar) do { unsigned _sp = 0; while (cond) { __builtin_amdgcn_s_sleep(1); \
    if ((++_sp & 255u) == 0u) { if (xb_ld(&(bar)[XB_TMO])) break; if (_sp > XB_SPIN_CAP) { atomicAdd(&(bar)[XB_TMO], 1u); break; } } } } while (0)
struct XcdBarrier { unsigned* bar; unsigned x; volatile LAS unsigned* st; };
__device__ __forceinline__ XcdBarrier xcd_barrier_post(unsigned* bar, volatile LAS unsigned* st) {
    XcdBarrier b; b.bar = bar; b.x = xb_xcc_id(); b.st = st;
    if (threadIdx.x == 0) (void)xb_add(&bar[XB_XCNT(b.x)], 1u);
    return b;
}
__device__ __forceinline__ void xcd_barrier_complete(unsigned* bar, unsigned x, unsigned& nloc, unsigned& nx) {
    const unsigned G = gridDim.x * gridDim.y * gridDim.z;
    unsigned sum, cnt, mine, sp = 0u;
    for (;;) {
        sum = 0u; cnt = 0u; mine = 0u;
#pragma unroll
        for (unsigned j = 0; j < 16; ++j) { const unsigned c = xb_ld(&bar[XB_XCNT(j)]); sum += c; cnt += (c > 0u) ? 1u : 0u; mine = (j == x) ? c : mine; }
        if (sum == G) break;
        __builtin_amdgcn_s_sleep(1);
        if ((++sp & 255u) == 0u) { if (xb_ld(&bar[XB_TMO])) break; if (sp > XB_SPIN_CAP) { atomicAdd(&bar[XB_TMO], 1u); break; } }
    }
    nloc = mine > 0u ? mine : 1u; nx = cnt > 0u ? cnt : 1u;
}
__device__ __forceinline__ void xcd_barrier(const XcdBarrier& b) {
    asm volatile("s_waitcnt vmcnt(0)" ::: "memory");
    __syncthreads();
    if (threadIdx.x == 0) {
        unsigned* bar = b.bar;
        __builtin_amdgcn_s_waitcnt(0);
        unsigned nloc = b.st[0], nx = b.st[1];
        if (nloc == 0u) { xcd_barrier_complete(bar, b.x, nloc, nx); b.st[0] = nloc; b.st[1] = nx; }
        const unsigned old = xb_add(&bar[XB_XSUB(b.x)], 1u);
        const unsigned gen = old / nloc;
        if (old + 1u == (gen + 1u) * nloc) {
            __builtin_amdgcn_fence(__ATOMIC_RELEASE, "agent");
            asm volatile("s_waitcnt vmcnt(0)" ::: "memory");
            const unsigned og = xb_add(&bar[XB_TOP], 1u);
            const unsigned tg = og / nx;
            if (og + 1u == (tg + 1u) * nx) xb_add(&bar[XB_TOPGEN], 1u);
            else XB_SPIN(xb_ld(&bar[XB_TOPGEN]) == tg, bar);
            __builtin_amdgcn_fence(__ATOMIC_ACQUIRE, "agent");
            xb_add(&bar[XB_XGEN(b.x)], 1u);
            asm volatile("s_waitcnt vmcnt(0)" ::: "memory");
        } else {
            XB_SPIN(xb_ld(&bar[XB_XGEN(b.x)]) == gen, bar);
            __builtin_amdgcn_fence(__ATOMIC_ACQUIRE, "agent");
            asm volatile("s_waitcnt vmcnt(0)" ::: "memory");
        }
    }
    __syncthreads();
}
typedef __bf16 bf16x2_t __attribute__((ext_vector_type(2)));
__device__ __forceinline__ uint32_t pk2(float lo, float hi) { typedef float f2 __attribute__((ext_vector_type(2))); const f2 v = {lo, hi}; return __builtin_bit_cast(uint32_t, __builtin_convertvector(v, bf16x2_t)); }
__device__ __forceinline__ float bflo(uint32_t u) { return __uint_as_float(u << 16); }
__device__ __forceinline__ float bfhi(uint32_t u) { return __uint_as_float(u & 0xffff0000u); }
__device__ __forceinline__ float max3f(float a, float b, float c) { float r; asm("v_max3_f32 %0, %1, %2, %3" : "=v"(r) : "v"(a), "v"(b), "v"(c)); return r; }
__device__ __forceinline__ void halves32(float x, float& lo_half, float& hi_half) {
    typedef unsigned int u2v __attribute__((ext_vector_type(2)));
    const u2v rr = __builtin_amdgcn_permlane32_swap(__builtin_bit_cast(unsigned, x), __builtin_bit_cast(unsigned, x), false, false);
    lo_half = __builtin_bit_cast(float, rr.x); hi_half = __builtin_bit_cast(float, rr.y);
}
__device__ __forceinline__ float ex2(float x) { return __builtin_amdgcn_exp2f(x); }
__device__ __forceinline__ float siluf(float x) { return x * __builtin_amdgcn_rcpf(1.f + __expf(-x)); }
__device__ __forceinline__ float sigmf(float x) { return __builtin_amdgcn_rcpf(1.f + __expf(-x)); }
__device__ __forceinline__ float wave_sum(float v) {
#pragma unroll
    for (int o = 1; o < 64; o <<= 1) v += __shfl_xor(v, o);
    return v;
}
__device__ __forceinline__ f32x16 mfma32(bf16x8 a, bf16x8 b, f32x16 c) { return __builtin_amdgcn_mfma_f32_32x32x16_bf16(a, b, c, 0, 0, 0); }
__device__ __forceinline__ f32x4 mfma16(bf16x8 a, bf16x8 b, f32x4 c) { return __builtin_amdgcn_mfma_f32_16x16x32_bf16(a, b, c, 0, 0, 0); }
__device__ __forceinline__ bf16x8 mk8(uint32_t a, uint32_t b, uint32_t c, uint32_t d) { u32x4 v = {a, b, c, d}; return __builtin_bit_cast(bf16x8, v); }

struct WDesc { const float* W; int ldw, K, Np, kind; bf16_t* Bt; const float* kgain; };
__device__ __forceinline__ int srccol(int kind, int n) {
    if (kind == 0) return n;
    if (kind == 1) { return 64 * (n >> 7) + 32 * ((n >> 6) & 1) + (n & 31) + ((n >> 5) & 1) * DFF; }
    if (kind == 3) return 4024 + n;
    if (n < 1536) return n;
    if (n < 1792) return 1544 + (n - 1536);
    if (n < 1920) return 1800 + (n - 1792);
    if (n < 3968) return 1960 + (n - 1920);
    int j = n - 3968;
    if (j < 8) return 1536 + j;
    if (j < 16) return 4008 + (j - 8);
    if (j < 24) return 4016 + (j - 16);
    if (j >= 32 && j < 64) return 1928 + (j - 32);
    return -1;
}
__device__ __forceinline__ WDesc wdesc(const Params& p, int l, int m) {
    bf16_t* wb = (bf16_t*)(p.ws + OFF_WB);
    WDesc d; d.kgain = nullptr; d.kind = 0;
    switch (m) {
    case 0: d.W = p.ffn1_gu + (size_t)l * 1024 * 5632; d.ldw = 5632; d.K = 1024; d.Np = 5632; d.kind = 1; d.Bt = wb + W_GU1; break;
    case 1: d.W = p.ffn1_down + (size_t)l * 2816 * 1024; d.ldw = 1024; d.K = 2816; d.Np = 1024; d.Bt = wb + W_DN1; break;
    case 2: d.W = p.w_in + (size_t)l * 1024 * NIN; d.ldw = NIN; d.K = 1024; d.Np = 4096; d.kind = 2; d.Bt = wb + W_IN; break;
    case 3: d.W = p.w_in + (size_t)l * 1024 * NIN; d.ldw = NIN; d.K = 1024; d.Np = 3072; d.kind = 3; d.Bt = wb + W_G; break;
    case 4: d.W = p.mla_uq + (size_t)l * 256 * 768; d.ldw = 768; d.K = 256; d.Np = 768; d.Bt = wb + W_UQ; d.kgain = p.mla_qn + l * 256; break;
    case 5: d.W = p.mla_ukv + (size_t)l * 128 * 1024; d.ldw = 1024; d.K = 128; d.Np = 1024; d.Bt = wb + W_UKV; d.kgain = p.mla_kvn + l * 128; break;
    case 6: d.W = p.br_fox + (size_t)l * 512 * 1024; d.ldw = 1024; d.K = 512; d.Np = 1024; d.Bt = wb + W_BRF; break;
    case 7: d.W = p.br_mla + (size_t)l * 512 * 1024; d.ldw = 1024; d.K = 512; d.Np = 1024; d.Bt = wb + W_BRM; break;
    case 8: d.W = p.br_dn + (size_t)l * 512 * 1024; d.ldw = 1024; d.K = 512; d.Np = 1024; d.Bt = wb + W_BRD; break;
    case 9: d.W = p.w_out + (size_t)l * 1024 * 1024; d.ldw = 1024; d.K = 1024; d.Np = 1024; d.Bt = wb + W_OUT; break;
    case 10: d.W = p.ffn2_gu + (size_t)l * 1024 * 5632; d.ldw = 5632; d.K = 1024; d.Np = 5632; d.kind = 1; d.Bt = wb + W_GU2; break;
    default: d.W = p.ffn2_down + (size_t)l * 2816 * 1024; d.ldw = 1024; d.K = 2816; d.Np = 1024; d.Bt = wb + W_DN2; break;
    }
    return d;
}
__device__ __forceinline__ void wconv_tile(const WDesc& d, int tile, float* lds) {
    const int tid = tidx();
    const int nkt = d.K >> 6;
    const int tk = tile % nkt, tn = tile / nkt;
    {
        const int n = (tn << 6) + (tid & 63);
        const int sc = srccol(d.kind, n);
#pragma unroll
        for (int r = 0; r < 16; ++r) {
            const int kk = (tid >> 6) + 4 * r;
            const int k = (tk << 6) + kk;
            float v = 0.f;
            if (sc >= 0) v = d.W[(size_t)k * d.ldw + sc];
            if (d.kgain) v *= d.kgain[k];
            lds[(tid & 63) * 65 + kk] = v;
        }
    }
    __syncthreads();
    {
        const int n = tid >> 2, k0 = (tid & 3) * 16;
        const float* s = lds + n * 65 + k0;
        u32x4 o0 = {pk2(s[0], s[1]), pk2(s[2], s[3]), pk2(s[4], s[5]), pk2(s[6], s[7])};
        u32x4 o1 = {pk2(s[8], s[9]), pk2(s[10], s[11]), pk2(s[12], s[13]), pk2(s[14], s[15])};
        bf16_t* dst = d.Bt + (size_t)((tn << 6) + n) * d.K + (tk << 6) + k0;
        *(u32x4*)dst = o0; *(u32x4*)(dst + 8) = o1;
    }
    __syncthreads();
}
__device__ __forceinline__ void phase_wconv(const Params& p, int l, unsigned char* lds) {
    int total = 0;
#pragma unroll 1
    for (int m = 0; m < 12; ++m) { WDesc d = wdesc(p, l, m); total += (d.K >> 6) * (d.Np >> 6); }
#pragma unroll 1
    for (int it = blockIdx.x; it < total; it += gridDim.x) {
        int r = it, m = 0;
#pragma unroll 1
        for (; m < 12; ++m) { WDesc d = wdesc(p, l, m); int c = (d.K >> 6) * (d.Np >> 6); if (r < c) break; r -= c; }
        WDesc d = wdesc(p, l, m);
        wconv_tile(d, r, (float*)lds);
    }
}

__device__ __forceinline__ void phase_rmsnorm(const float* x, const float* gain, bf16_t* outb, float* outf) {
    const int lane = tidx() & 63, wave = tidx() >> 6;
    f32x4 g[4];
#pragma unroll
    for (int j = 0; j < 4; ++j) g[j] = *(const f32x4*)(gain + lane * 4 + 256 * j);
#pragma unroll 1
    for (int row = blockIdx.x * 4 + wave; row < TOK; row += gridDim.x * 4) {
        const float* xr = x + (size_t)row * DM + lane * 4;
        f32x4 v[4]; float s = 0.f;
#pragma unroll
        for (int j = 0; j < 4; ++j) { v[j] = *(const f32x4*)(xr + 256 * j); s += v[j].x * v[j].x + v[j].y * v[j].y + v[j].z * v[j].z + v[j].w * v[j].w; }
        s = wave_sum(s);
        const float r = rsqrtf(s * (1.f / DM) + EPS);
#pragma unroll
        for (int j = 0; j < 4; ++j) {
            f32x4 o = v[j] * r * g[j];
            if (outb) { u32x2 w = {pk2(o.x, o.y), pk2(o.z, o.w)}; *(u32x2*)(outb + (size_t)row * DM + lane * 4 + 256 * j) = w; }
            else *(f32x4*)(outf + (size_t)row * DM + lane * 4 + 256 * j) = o;
        }
    }
}

constexpr int GLD = 72;
template <int NI>
__device__ __forceinline__ void gemm_core(const bf16_t* __restrict__ A, long lda, int acs, const bf16_t* __restrict__ Bt, int K,
                                          f32x16 (&acc)[2][NI], unsigned char* lds) {
    const int tid = tidx(), lane = tid & 63, wave = tid >> 6, wr = wave >> 1, wc = wave & 1;
    const int r = lane & 31, h = lane >> 5;
    constexpr int ABYTES = 128 * 128, BBYTES = 64 * NI * 128, STAGE = ABYTES + BBYTES;
    const int nk = K >> 6;
    const int lrow = tid >> 3, lp = tid & 7;
    auto issue = [&](int kc, int buf) {
        unsigned char* sb = lds + buf * STAGE;
#pragma unroll
        for (int i = 0; i < 4; ++i) {
            const int row = lrow + 32 * i, c = lp ^ ((row >> 1) & 7);
            __builtin_amdgcn_global_load_lds((const unsigned*)(A + (long)row * lda + (long)kc * acs + c * 8), (unsigned*)(sb + (i * 256 + tid) * 16), 16, 0, 0);
        }
#pragma unroll
        for (int i = 0; i < 2 * NI; ++i) {
            const int row = lrow + 32 * i, c = lp ^ ((row >> 1) & 7);
            __builtin_amdgcn_global_load_lds((const unsigned*)(Bt + (long)row * K + kc * 64 + c * 8), (unsigned*)(sb + ABYTES + (i * 256 + tid) * 16), 16, 0, 0);
        }
    };
    const int ra0 = wr * 64 + r, ra1 = ra0 + 32;
    const int fa0 = (ra0 >> 1) & 7, fa1 = (ra1 >> 1) & 7;
    __syncthreads();
    issue(0, 0);
#pragma unroll 1
    for (int kc = 0; kc < nk; ++kc) {
        asm volatile("s_waitcnt vmcnt(0)" ::: "memory");
        lds_barrier();
        const unsigned char* sa = lds + (kc & 1) * STAGE;
        const unsigned char* sbb = sa + ABYTES;
        bf16x8 af[4][2], bfr[4][NI];
#pragma unroll
        for (int ks = 0; ks < 4; ++ks) {
            const int c = 2 * ks + h;
            af[ks][0] = *(const bf16x8*)(sa + ra0 * 128 + ((c ^ fa0) << 4));
            af[ks][1] = *(const bf16x8*)(sa + ra1 * 128 + ((c ^ fa1) << 4));
#pragma unroll
            for (int ni = 0; ni < NI; ++ni) {
                const int rb = wc * 32 * NI + ni * 32 + r;
                bfr[ks][ni] = *(const bf16x8*)(sbb + rb * 128 + ((c ^ ((rb >> 1) & 7)) << 4));
            }
        }
        if (kc + 1 < nk) issue(kc + 1, (kc + 1) & 1);
#pragma unroll
        for (int ks = 0; ks < 4; ++ks)
#pragma unroll
            for (int ni = 0; ni < NI; ++ni) { acc[0][ni] = mfma32(af[ks][0], bfr[ks][ni], acc[0][ni]); acc[1][ni] = mfma32(af[ks][1], bfr[ks][ni], acc[1][ni]); }
    }
    asm volatile("s_waitcnt lgkmcnt(0)" ::: "memory");
}
__device__ __forceinline__ void gemm_big(const bf16_t* __restrict__ A, long lda, const bf16_t* __restrict__ Bt, int K, f32x16 (&acc)[2][4], unsigned char* lds) {
    const int tid = tidx(), lane = tid & 63, wave = tid >> 6, wr = wave >> 1, wc = wave & 1;
    const int r = lane & 31, h = lane >> 5;
    bf16_t* As = (bf16_t*)lds;
    bf16_t* Bs = As + 128 * GLD;
    const int nk = K >> 6;
    const int lrow = tid >> 3, lc = tid & 7;
    const bf16_t* ap = A + (long)lrow * lda + lc * 8;
    const bf16_t* bp = Bt + (long)lrow * K + lc * 8;
    u32x4 ra[4], rb[8];
    auto gload = [&](int kc) {
#pragma unroll
        for (int i = 0; i < 4; ++i) ra[i] = *(const u32x4*)(ap + (long)(32 * i) * lda + kc * 64);
#pragma unroll
        for (int i = 0; i < 8; ++i) rb[i] = *(const u32x4*)(bp + (long)(32 * i) * K + kc * 64);
    };
    auto lstore = [&]() {
#pragma unroll
        for (int i = 0; i < 4; ++i) *(u32x4*)(As + (lrow + 32 * i) * GLD + lc * 8) = ra[i];
#pragma unroll
        for (int i = 0; i < 8; ++i) *(u32x4*)(Bs + (lrow + 32 * i) * GLD + lc * 8) = rb[i];
    };
    const bf16_t* Ac = As + (wr * 64 + r) * GLD + h * 8;
    const bf16_t* Bc = Bs + (wc * 128 + r) * GLD + h * 8;
    gload(0);
    __syncthreads();
    lstore();
    if (nk > 1) gload(1);
    lds_barrier();
#pragma unroll 1
    for (int kc = 0; kc < nk; ++kc) {
        bf16x8 af[2][2], bfr[2][4];
        af[0][0] = *(const bf16x8*)(Ac); af[0][1] = *(const bf16x8*)(Ac + 32 * GLD);
#pragma unroll
        for (int ni = 0; ni < 4; ++ni) bfr[0][ni] = *(const bf16x8*)(Bc + ni * 32 * GLD);
        __builtin_amdgcn_s_setprio(3);
#pragma unroll
        for (int ks = 0; ks < 4; ++ks) {
            const int cb = ks & 1, nb = cb ^ 1;
            if (ks < 3) {
                af[nb][0] = *(const bf16x8*)(Ac + (ks + 1) * 16); af[nb][1] = *(const bf16x8*)(Ac + 32 * GLD + (ks + 1) * 16);
#pragma unroll
                for (int ni = 0; ni < 4; ++ni) bfr[nb][ni] = *(const bf16x8*)(Bc + ni * 32 * GLD + (ks + 1) * 16);
            }
            __builtin_amdgcn_sched_barrier(0);
#pragma unroll
            for (int ni = 0; ni < 4; ++ni) { acc[0][ni] = mfma32(af[cb][0], bfr[cb][ni], acc[0][ni]); acc[1][ni] = mfma32(af[cb][1], bfr[cb][ni], acc[1][ni]); }
            __builtin_amdgcn_sched_barrier(0);
        }
        __builtin_amdgcn_s_setprio(0);
        lds_barrier();
        if (kc + 1 < nk) {
            lstore();
            if (kc + 2 < nk) gload(kc + 2);
            lds_barrier();
        }
    }
}
#define ZERO_ACC4(acc) { _Pragma("unroll") for (int _a = 0; _a < 2; ++_a) { _Pragma("unroll") for (int _b = 0; _b < 4; ++_b) { _Pragma("unroll") for (int _c = 0; _c < 16; ++_c) acc[_a][_b][_c] = 0.f; } } }
__device__ __forceinline__ bool tile_at(int k, int NPM, int NPN, int& pm, int& pn) {
    const int nb = gridDim.x >> 3, x = blockIdx.x & 7, jb = blockIdx.x >> 3;
    const int t = jb + k * nb, perx = (NPM >> 3) * NPN;
    if (t >= perx) return false;
    const int pmg = t / (8 * NPN), rem = t - pmg * 8 * NPN;
    pn = rem >> 3; pm = x * (NPM >> 3) + pmg * 8 + (rem & 7);
    return true;
}
#define ZERO_ACC(acc) { _Pragma("unroll") for (int _a = 0; _a < 2; ++_a) { _Pragma("unroll") for (int _b = 0; _b < 2; ++_b) { _Pragma("unroll") for (int _c = 0; _c < 16; ++_c) acc[_a][_b][_c] = 0.f; } } }

__device__ __forceinline__ void phase_gu(const Params& p, const bf16_t* wgu, unsigned char* lds) {
    const bf16_t* hb = (const bf16_t*)(p.ws + OFF_HB);
    bf16_t* act = (bf16_t*)(p.ws + OFF_BIG);
    const int lane = tidx() & 63, wave = tidx() >> 6, wr = wave >> 1, wc = wave & 1, r = lane & 31, h = lane >> 5;
    constexpr int NPN = 5632 / 256;
    int pm, pn;
#pragma unroll 1
    for (int k = 0; tile_at(k, TOK / 128, NPN, pm, pn); ++k) {
        f32x16 acc[2][4]; ZERO_ACC4(acc);
        gemm_big(hb + (size_t)pm * 128 * DM, DM, wgu + (size_t)pn * 256 * DM, DM, acc, lds);
#pragma unroll
        for (int gq = 0; gq < 2; ++gq) {
            const int a = pn * 128 + wc * 64 + gq * 32 + r;
#pragma unroll
            for (int mi = 0; mi < 2; ++mi)
#pragma unroll
                for (int reg = 0; reg < 16; ++reg) {
                    const int m = pm * 128 + wr * 64 + mi * 32 + (reg & 3) + 8 * (reg >> 2) + 4 * h;
                    const float g = acc[mi][2 * gq][reg], u = acc[mi][2 * gq + 1][reg];
                    const float v = siluf(g) * u;
                    act[(size_t)m * DFF + a] = (bf16_t)(pk2(v, 0.f) & 0xffff);
                }
        }
    }
}
__device__ __forceinline__ void phase_resid(const Params& p, const bf16_t* A, long lda, int mrows, const bf16_t* Bt, int K, float* xres, float scale, unsigned char* lds) {
    const int lane = tidx() & 63, wave = tidx() >> 6, wr = wave >> 1, wc = wave & 1, r = lane & 31, h = lane >> 5;
    int pm, pn;
#pragma unroll 1
    for (int k = 0; tile_at(k, mrows / 128, 4, pm, pn); ++k) {
        f32x16 acc[2][4]; ZERO_ACC4(acc);
        gemm_big(A + (size_t)pm * 128 * lda, lda, Bt + (size_t)pn * 256 * K, K, acc, lds);
#pragma unroll
        for (int mi = 0; mi < 2; ++mi)
#pragma unroll
            for (int ni = 0; ni < 4; ++ni)
#pragma unroll
                for (int reg = 0; reg < 16; ++reg) {
                    const int m = pm * 128 + wr * 64 + mi * 32 + (reg & 3) + 8 * (reg >> 2) + 4 * h;
                    const int n = pn * 256 + wc * 128 + ni * 32 + r;
                    float* q = xres + (size_t)m * DM + n;
                    *q = *q + scale * acc[mi][ni][reg];
                }
    }
}
__device__ __forceinline__ void phase_win(const Params& p, int b, unsigned char* lds) {
    const bf16_t* hb = (const bf16_t*)(p.ws + OFF_HB) + (size_t)b * TH * DM;
    const bf16_t* wt = (const bf16_t*)(p.ws + OFF_WB) + W_IN;
    bf16_t* PB = (bf16_t*)(p.ws + OFF_PB);
    bf16_t* VTF = (bf16_t*)(p.ws + OFF_VTF);
    float* S32 = (float*)(p.ws + OFF_S32);
    const int lane = tidx() & 63, wave = tidx() >> 6, wr = wave >> 1, wc = wave & 1, r = lane & 31, h = lane >> 5;
    const float qscale = 0.125f * LOG2E;
    int pm, pn;
#pragma unroll 1
    for (int k = 0; tile_at(k, TH / 128, 16, pm, pn); ++k) {
        f32x16 acc[2][4]; ZERO_ACC4(acc);
        gemm_big(hb + (size_t)pm * 128 * DM, DM, wt + (size_t)pn * 256 * DM, DM, acc, lds);
#pragma unroll
        for (int ni = 0; ni < 4; ++ni) {
            const int nb = pn * 256 + wc * 128 + ni * 32;
            const int n = nb + r;
#pragma unroll
            for (int mi = 0; mi < 2; ++mi) {
                const int mb = pm * 128 + wr * 64 + mi * 32 + 4 * h;
                if (nb >= 1024 && nb < 1536) {
#pragma unroll
                    for (int g = 0; g < 4; ++g) {
                        u32x2 w = {pk2(acc[mi][ni][4 * g], acc[mi][ni][4 * g + 1]), pk2(acc[mi][ni][4 * g + 2], acc[mi][ni][4 * g + 3])};
                        *(u32x2*)(VTF + (size_t)(n - 1024) * TH + mb + 8 * g) = w;
                    }
                } else if (nb >= 3968) {
                    const int j = n - 3968;
                    if (j < 64) {
#pragma unroll
                        for (int reg = 0; reg < 16; ++reg) S32[(size_t)(mb + (reg & 3) + 8 * (reg >> 2)) * 64 + j] = acc[mi][ni][reg];
                    }
                } else {
                    const float sc = (nb < 512) ? qscale : 1.f;
#pragma unroll
                    for (int reg = 0; reg < 16; ++reg)
                        PB[(size_t)(mb + (reg & 3) + 8 * (reg >> 2)) * PBW + n] = (bf16_t)(pk2(acc[mi][ni][reg] * sc, 0.f) & 0xffff);
                }
            }
        }
    }
}

__device__ __forceinline__ void fox_cumsum_item(const Params& p, int l, int hd, unsigned char* lds) {
    const float* S32 = (const float*)(p.ws + OFF_S32);
    float* CF = (float*)(p.ws + OFF_CF) + (size_t)hd * TH;
    float* sw = (float*)lds;
    const int tid = tidx(), lane = tid & 63, wave = tid >> 6;
    const float bf = p.fox_bf[l * 8 + hd];
    float loc = 0.f;
#pragma unroll 4
    for (int e = 0; e < 64; ++e) { float x = S32[(size_t)(tid * 64 + e) * 64 + hd] + bf; loc += fminf(x, 0.f) - log1pf(__expf(-fabsf(x))); }
    float v = loc;
#pragma unroll
    for (int o = 1; o < 64; o <<= 1) { float u = __shfl_up(v, o); if (lane >= o) v += u; }
    if (lane == 63) sw[wave] = v;
    __syncthreads();
    float base = v - loc;
    for (int w = 0; w < wave; ++w) base += sw[w];
    float run = base;
#pragma unroll 4
    for (int e = 0; e < 64; ++e) { float x = S32[(size_t)(tid * 64 + e) * 64 + hd] + bf; run += fminf(x, 0.f) - log1pf(__expf(-fabsf(x))); CF[tid * 64 + e] = run * LOG2E; }
    __syncthreads();
}
__device__ __forceinline__ void mla_rows_item(const Params& p, int b, int item, unsigned* nrm) {
    const bf16_t* PB = (const bf16_t*)(p.ws + OFF_PB);
    const float* S32 = (const float*)(p.ws + OFF_S32);
    const float* rope = (const float*)(p.ws + OFF_ROPE);
    float* RQ = (float*)(p.ws + OFF_RQ); float* RKV = (float*)(p.ws + OFF_RKV);
    bf16_t* KM = (bf16_t*)(p.ws + OFF_KM);
    const int lane = tidx() & 63, wave = tidx() >> 6;
    float qmx = 0.f, kmx = 0.f;
#pragma unroll 1
    for (int e = 0; e < 16; ++e) {
        const int m = item * 64 + wave * 16 + e;
        u32x2 cq = *(const u32x2*)(PB + (size_t)m * PBW + PB_CQ + lane * 4);
        uint32_t ck = *(const uint32_t*)(PB + (size_t)m * PBW + PB_CKV + lane * 2);
        float s1 = bflo(cq.x) * bflo(cq.x) + bfhi(cq.x) * bfhi(cq.x) + bflo(cq.y) * bflo(cq.y) + bfhi(cq.y) * bfhi(cq.y);
        float s2 = bflo(ck) * bflo(ck) + bfhi(ck) * bfhi(ck);
        s1 = wave_sum(s1); s2 = wave_sum(s2);
        if (lane == 0) { RQ[m] = rsqrtf(s1 * (1.f / 256.f) + EPS); RKV[m] = rsqrtf(s2 * (1.f / 128.f) + EPS); }
        {
            const u32x4 fq = *(const u32x4*)(PB + (size_t)m * PBW + lane * 8);
            const u32x4 fk = *(const u32x4*)(PB + (size_t)m * PBW + 512 + lane * 8);
            float a = bflo(fq.x) * bflo(fq.x) + bfhi(fq.x) * bfhi(fq.x) + bflo(fq.y) * bflo(fq.y) + bfhi(fq.y) * bfhi(fq.y)
                    + bflo(fq.z) * bflo(fq.z) + bfhi(fq.z) * bfhi(fq.z) + bflo(fq.w) * bflo(fq.w) + bfhi(fq.w) * bfhi(fq.w);
            float c = bflo(fk.x) * bflo(fk.x) + bfhi(fk.x) * bfhi(fk.x) + bflo(fk.y) * bflo(fk.y) + bfhi(fk.y) * bfhi(fk.y)
                    + bflo(fk.z) * bflo(fk.z) + bfhi(fk.z) * bfhi(fk.z) + bflo(fk.w) * bflo(fk.w) + bfhi(fk.w) * bfhi(fk.w);
            a += __shfl_xor(a, 1); a += __shfl_xor(a, 2); a += __shfl_xor(a, 4);
            c += __shfl_xor(c, 1); c += __shfl_xor(c, 2); c += __shfl_xor(c, 4);
            qmx = fmaxf(qmx, a); kmx = fmaxf(kmx, c);
        }
        const int hd = lane >> 3, j0 = (lane & 7) * 2;
        const float* rp = rope + (size_t)(b * TH + m) * 32;
        const float* kr = S32 + (size_t)m * 64 + 32;
        float x1a = kr[j0], x1b = kr[j0 + 1], x2a = kr[16 + j0], x2b = kr[16 + j0 + 1];
        float ca = rp[j0], cb = rp[j0 + 1], sa = rp[16 + j0], sb = rp[16 + j0 + 1];
        bf16_t* dst = KM + ((size_t)m * 8 + hd) * 96 + 64;
        *(uint32_t*)(dst + j0) = pk2(x1a * ca - x2a * sa, x1b * cb - x2b * sb);
        *(uint32_t*)(dst + 16 + j0) = pk2(x2a * ca + x1a * sa, x2b * cb + x1b * sb);
    }
    if ((lane & 7) == 0) { atomicMax(&nrm[lane >> 3], __float_as_uint(qmx)); atomicMax(&nrm[8 + (lane >> 3)], __float_as_uint(kmx)); }
}

constexpr int DLD = 68;
__device__ __forceinline__ void mm64(const float* At, const float* B, float (&acc)[4][4], int ty, int tx) {
    f32x2 c2[4][2];
#pragma unroll
    for (int rr = 0; rr < 4; ++rr) { c2[rr][0] = (f32x2){acc[rr][0], acc[rr][1]}; c2[rr][1] = (f32x2){acc[rr][2], acc[rr][3]}; }
#pragma unroll 8
    for (int k = 0; k < 64; ++k) {
        const f32x4 a = *(const f32x4*)(At + k * DLD + 4 * ty);
        const f32x4 b = *(const f32x4*)(B + k * DLD + 4 * tx);
        const f32x2 b01 = {b.x, b.y}, b23 = {b.z, b.w};
#pragma unroll
        for (int rr = 0; rr < 4; ++rr) {
            const f32x2 a2 = {a[rr], a[rr]};
            c2[rr][0] = __builtin_elementwise_fma(a2, b01, c2[rr][0]);
            c2[rr][1] = __builtin_elementwise_fma(a2, b23, c2[rr][1]);
        }
    }
#pragma unroll
    for (int rr = 0; rr < 4; ++rr) { acc[rr][0] = c2[rr][0].x; acc[rr][1] = c2[rr][0].y; acc[rr][2] = c2[rr][1].x; acc[rr][3] = c2[rr][1].y; }
}
#define ZERO44(a) { _Pragma("unroll") for (int _i = 0; _i < 4; ++_i) { _Pragma("unroll") for (int _j = 0; _j < 4; ++_j) a[_i][_j] = 0.f; } }

__device__ __forceinline__ void dn_conv16(const bf16_t* PB, const float* cw, int t0, int i, int col, int ch, float (&o)[16]) {
#pragma unroll
    for (int e = 0; e < 16; ++e) o[e] = 0.f;
#pragma unroll
    for (int tap = 0; tap < 4; ++tap) {
        const int mm = t0 + i - 3 + tap;
        if (mm >= 0) {
            const u32x4 x0 = *(const u32x4*)(PB + (size_t)mm * PBW + col);
            const u32x4 x1 = *(const u32x4*)(PB + (size_t)mm * PBW + col + 8);
            const float* w = cw + tap * 1536 + ch;
            const f32x4 w0 = *(const f32x4*)w, w1 = *(const f32x4*)(w + 4), w2 = *(const f32x4*)(w + 8), w3 = *(const f32x4*)(w + 12);
            o[0] += w0.x * bflo(x0.x); o[1] += w0.y * bfhi(x0.x); o[2] += w0.z * bflo(x0.y); o[3] += w0.w * bfhi(x0.y);
            o[4] += w1.x * bflo(x0.z); o[5] += w1.y * bfhi(x0.z); o[6] += w1.z * bflo(x0.w); o[7] += w1.w * bfhi(x0.w);
            o[8] += w2.x * bflo(x1.x); o[9] += w2.y * bfhi(x1.x); o[10] += w2.z * bflo(x1.y); o[11] += w2.w * bfhi(x1.y);
            o[12] += w3.x * bflo(x1.z); o[13] += w3.y * bfhi(x1.z); o[14] += w3.z * bflo(x1.w); o[15] += w3.w * bfhi(x1.w);
        }
    }
#pragma unroll
    for (int e = 0; e < 16; ++e) o[e] = siluf(o[e]);
}

__device__ __forceinline__ void dn1_item(const Params& p, int l, int item, unsigned char* lds) {
    const bf16_t* PB = (const bf16_t*)(p.ws + OFF_PB);
    const float* S32 = (const float*)(p.ws + OFF_S32);
    float* DNA = (float*)(p.ws + OFF_DNA) + (size_t)item * 4096;
    float* DNB = (float*)(p.ws + OFF_DNB) + (size_t)item * 4096;
    float* DNQ = (float*)(p.ws + OFF_DNQ) + (size_t)item * 4096;
    float* DNO = (float*)(p.ws + OFF_DNO) + (size_t)item * 4096;
    float* B0 = (float*)lds; float* B1 = B0 + 64 * DLD; float* B2 = B1 + 64 * DLD; float* B3 = B2 + 64 * DLD;
    float* sgc = B3 + 64 * DLD; float* sbeta = sgc + 64;
    const int tid = tidx(), lane = tid & 63, wave = tid >> 6;
    const int i = tid >> 2, seg = tid & 3, d0 = seg * 16, ty = tid >> 4, tx = tid & 15;
    const int cchunk = item >> 3, hd = item & 7, t0 = cchunk * 64;
    const float* cw = p.dn_conv + (size_t)l * 4 * 1536;
    float qn[16], kn[16], vv[16];
    dn_conv16(PB, cw, t0, i, PB_DN + hd * 64 + d0, hd * 64 + d0, qn);
    dn_conv16(PB, cw, t0, i, PB_DN + 512 + hd * 64 + d0, 512 + hd * 64 + d0, kn);
    dn_conv16(PB, cw, t0, i, PB_DN + 1024 + hd * 64 + d0, 1024 + hd * 64 + d0, vv);
    {
        float sq = 0.f, sk = 0.f;
#pragma unroll
        for (int e = 0; e < 16; ++e) { sq += qn[e] * qn[e]; sk += kn[e] * kn[e]; }
        sq += __shfl_xor(sq, 1); sq += __shfl_xor(sq, 2);
        sk += __shfl_xor(sk, 1); sk += __shfl_xor(sk, 2);
        const float rq = rsqrtf(sq + EPS) * 0.125f, rk = rsqrtf(sk + EPS);
#pragma unroll
        for (int e = 0; e < 16; ++e) { qn[e] *= rq; kn[e] *= rk; }
    }
    __syncthreads();
#pragma unroll
    for (int e = 0; e < 16; ++e) { B0[(d0 + e) * DLD + i] = kn[e]; B1[(d0 + e) * DLD + i] = qn[e]; }
    if (seg == 0) {
        const float a = S32[(size_t)(t0 + i) * 64 + 16 + hd], bb = S32[(size_t)(t0 + i) * 64 + 8 + hd];
        const float xx = a + p.dn_dtb[l * 8 + hd];
        const float sp = (xx > 20.f) ? xx : log1pf(__expf(xx));
        sgc[i] = -__expf(p.dn_alog[l * 8 + hd]) * sp;
        sbeta[i] = sigmf(bb);
    }
    __syncthreads();
    if (wave == 0) {
        float v = sgc[lane];
#pragma unroll
        for (int o = 1; o < 64; o <<= 1) { float u = __shfl_up(v, o); if (lane >= o) v += u; }
        sgc[lane] = v;
    }
    __syncthreads();
    const float gci = sgc[i], beti = sbeta[i], gcl = sgc[63];
    const float gl = __expf(gcl);
    {
        float a1[4][4], a2[4][4]; ZERO44(a1); ZERO44(a2);
        mm64(B0, B0, a1, ty, tx);
        mm64(B1, B0, a2, ty, tx);
#pragma unroll
        for (int rr = 0; rr < 4; ++rr) {
            const int ii = 4 * ty + rr; const float gi = sgc[ii], bi = sbeta[ii];
#pragma unroll
            for (int cc = 0; cc < 4; ++cc) {
                const int jj = 4 * tx + cc; const float gj = sgc[jj];
                const float dec = (ii >= jj) ? __expf(gi - gj) : 0.f;
                B2[ii * DLD + jj] = (ii > jj) ? bi * a1[rr][cc] * dec : 0.f;
                B3[jj * DLD + ii] = a2[rr][cc] * dec;
            }
        }
    }
    __syncthreads();
    {
        const float s = beti * __expf(gci);
#pragma unroll
        for (int e = 0; e < 16; e += 4) { f32x4 w = {kn[e] * s, kn[e + 1] * s, kn[e + 2] * s, kn[e + 3] * s}; *(f32x4*)(B1 + i * DLD + d0 + e) = w; }
    }
    {
        float* Xs = sbeta + 64;
#pragma unroll
        for (int e = 0; e < 16; e += 4) { f32x4 z = {0.f, 0.f, 0.f, 0.f}; *(f32x4*)(B0 + i * DLD + d0 + e) = z; }
        __syncthreads();
        if (lane < 16) {
            const int base = 16 * wave;
            float t[16];
#pragma unroll
            for (int rr = 0; rr < 16; ++rr) {
                float sacc = (rr == lane) ? 1.f : 0.f;
#pragma unroll
                for (int m = 0; m < rr; ++m) sacc -= B2[(base + rr) * DLD + base + m] * t[m];
                t[rr] = sacc;
            }
#pragma unroll
            for (int rr = 0; rr < 16; rr += 4) { f32x4 w = {t[rr], t[rr + 1], t[rr + 2], t[rr + 3]}; *(f32x4*)(B0 + (base + lane) * DLD + base + rr) = w; }
        }
        __syncthreads();
        const int br = tid >> 4, bc = tid & 15;
#pragma unroll 1
        for (int bi = 1; bi < 4; ++bi) {
#pragma unroll 1
            for (int bj = 0; bj < bi; ++bj) {
                float x = 0.f;
#pragma unroll 1
                for (int bk = bj; bk < bi; ++bk) {
                    const float* mp = B2 + (16 * bi + br) * DLD + 16 * bk;
                    const float* tp = B0 + (16 * bj + bc) * DLD + 16 * bk;
#pragma unroll
                    for (int m = 0; m < 16; m += 4) {
                        const f32x4 a = *(const f32x4*)(mp + m), t4 = *(const f32x4*)(tp + m);
                        x += a.x * t4.x + a.y * t4.y + a.z * t4.z + a.w * t4.w;
                    }
                }
                Xs[bj * 256 + br * 16 + bc] = x;
            }
            __syncthreads();
#pragma unroll 1
            for (int bj = 0; bj < bi; ++bj) {
                float y = 0.f;
#pragma unroll
                for (int m = 0; m < 16; ++m) y += B0[(16 * bi + m) * DLD + 16 * bi + br] * Xs[bj * 256 + m * 16 + bc];
                B0[(16 * bj + bc) * DLD + 16 * bi + br] = -y;
            }
            __syncthreads();
        }
    }
    __syncthreads();
    float wacc[4][4], uacc[4][4]; ZERO44(wacc); ZERO44(uacc);
    mm64(B0, B1, wacc, ty, tx);
#pragma unroll
    for (int e = 0; e < 16; e += 4) { f32x4 w = {vv[e] * beti, vv[e + 1] * beti, vv[e + 2] * beti, vv[e + 3] * beti}; *(f32x4*)(B2 + i * DLD + d0 + e) = w; }
    __syncthreads();
    mm64(B0, B2, uacc, ty, tx);
    __syncthreads();
#pragma unroll
    for (int rr = 0; rr < 4; ++rr) {
        f32x4 w = {wacc[rr][0], wacc[rr][1], wacc[rr][2], wacc[rr][3]}; *(f32x4*)(B1 + (4 * ty + rr) * DLD + 4 * tx) = w;
        f32x4 u = {uacc[rr][0], uacc[rr][1], uacc[rr][2], uacc[rr][3]}; *(f32x4*)(B2 + (4 * ty + rr) * DLD + 4 * tx) = u;
    }
    {
        const float s = __expf(gcl - gci);
#pragma unroll
        for (int e = 0; e < 16; e += 4) { f32x4 w = {kn[e] * s, kn[e + 1] * s, kn[e + 2] * s, kn[e + 3] * s}; *(f32x4*)(B0 + i * DLD + d0 + e) = w; }
    }
    __syncthreads();
    {
        float a1[4][4]; ZERO44(a1);
        mm64(B0, B1, a1, ty, tx);
#pragma unroll
        for (int rr = 0; rr < 4; ++rr) {
            f32x4 w;
#pragma unroll
            for (int cc = 0; cc < 4; ++cc) w[cc] = ((4 * ty + rr) == (4 * tx + cc) ? gl : 0.f) - a1[rr][cc];
            *(f32x4*)(DNA + (4 * ty + rr) * 64 + 4 * tx) = w;
        }
        ZERO44(a1);
        mm64(B0, B2, a1, ty, tx);
#pragma unroll
        for (int rr = 0; rr < 4; ++rr) { f32x4 w = {a1[rr][0], a1[rr][1], a1[rr][2], a1[rr][3]}; *(f32x4*)(DNB + (4 * ty + rr) * 64 + 4 * tx) = w; }
    }
    float hacc[4][4]; ZERO44(hacc);
    mm64(B1, B3, hacc, ty, tx);
    {
        float a1[4][4]; ZERO44(a1);
        mm64(B3, B2, a1, ty, tx);
#pragma unroll
        for (int rr = 0; rr < 4; ++rr) { f32x4 w = {a1[rr][0], a1[rr][1], a1[rr][2], a1[rr][3]}; *(f32x4*)(DNO + (4 * ty + rr) * 64 + 4 * tx) = w; }
    }
    __syncthreads();
    {
        const float s = __expf(gci);
#pragma unroll
        for (int e = 0; e < 16; e += 4) { f32x4 w = {qn[e] * s, qn[e + 1] * s, qn[e + 2] * s, qn[e + 3] * s}; *(f32x4*)(B0 + i * DLD + d0 + e) = w; }
    }
    __syncthreads();
#pragma unroll
    for (int rr = 0; rr < 4; ++rr) {
        f32x4 w;
#pragma unroll
        for (int cc = 0; cc < 4; ++cc) w[cc] = B0[(4 * tx + cc) * DLD + 4 * ty + rr] - hacc[rr][cc];
        *(f32x4*)(DNQ + (4 * ty + rr) * 64 + 4 * tx) = w;
    }
    __syncthreads();
}

__device__ __forceinline__ void split8(const f32x4 a, const f32x4 b, bf16x8& hi, bf16x8& lo) {
    const uint32_t h0 = pk2(a.x, a.y), h1 = pk2(a.z, a.w), h2 = pk2(b.x, b.y), h3 = pk2(b.z, b.w);
    const uint32_t l0 = pk2(a.x - bflo(h0), a.y - bfhi(h0)), l1 = pk2(a.z - bflo(h1), a.w - bfhi(h1));
    const uint32_t l2 = pk2(b.x - bflo(h2), b.y - bfhi(h2)), l3 = pk2(b.z - bflo(h3), b.w - bfhi(h3));
    hi = mk8(h0, h1, h2, h3); lo = mk8(l0, l1, l2, l3);
}
constexpr int ALD = 72;
__device__ __forceinline__ void dn2_block(const Params& p, int hd, unsigned char* lds) {
    const float* DNA = (const float*)(p.ws + OFF_DNA);
    const float* DNB = (const float*)(p.ws + OFF_DNB);
    float* DNS = (float*)(p.ws + OFF_DNS);
    const int tid = tidx(), lane = tid & 63, vg = tid >> 6, c = lane & 15, q = lane >> 4;
    bf16_t* Ah = (bf16_t*)lds;
    f32x4 st[4];
#pragma unroll
    for (int mt = 0; mt < 4; ++mt) st[mt] = (f32x4){0.f, 0.f, 0.f, 0.f};
    f32x4 ga[3][4], gb[3][4];
    auto gload = [&](int d, int n) {
        const float* Ab = DNA + (size_t)(n * 8 + hd) * 4096; const float* Bb = DNB + (size_t)(n * 8 + hd) * 4096;
#pragma unroll
        for (int e = 0; e < 4; ++e) { const int id = tid + 256 * e; ga[d][e] = *(const f32x4*)(Ab + (id >> 4) * 64 + (id & 15) * 4); }
#pragma unroll
        for (int mt = 0; mt < 4; ++mt)
#pragma unroll
            for (int ii = 0; ii < 4; ++ii) gb[d][mt][ii] = Bb[(16 * mt + 4 * q + ii) * 64 + 16 * vg + c];
    };
    auto lstore = [&](int d, int buf) {
#pragma unroll
        for (int e = 0; e < 4; ++e) {
            const int id = tid + 256 * e, row = id >> 4, k = (id & 15) * 4;
            const int pos = (k >> 5) * 32 + ((k >> 2) & 3) * 8 + ((k >> 4) & 1) * 4;
            const f32x4 a = ga[d][e];
            const uint32_t h0 = pk2(a.x, a.y), h1 = pk2(a.z, a.w);
            const uint32_t l0 = pk2(a.x - bflo(h0), a.y - bfhi(h0)), l1 = pk2(a.z - bflo(h1), a.w - bfhi(h1));
            u32x2 hv = {h0, h1}, lv = {l0, l1};
            *(u32x2*)(Ah + (buf * 2 + 0) * 64 * ALD + row * ALD + pos) = hv;
            *(u32x2*)(Ah + (buf * 2 + 1) * 64 * ALD + row * ALD + pos) = lv;
        }
    };
    auto step = [&](int d, int n) {
        if (n + 1 < 256) lstore((d + 1) % 3, (n + 1) & 1);
        float* Sb = DNS + (size_t)(n * 8 + hd) * 4096;
#pragma unroll
        for (int mt = 0; mt < 4; ++mt)
#pragma unroll
            for (int ii = 0; ii < 4; ++ii) Sb[(16 * mt + 4 * q + ii) * 64 + 16 * vg + c] = st[mt][ii];
        bf16x8 shi[2], slo[2];
        split8(st[0], st[1], shi[0], slo[0]);
        split8(st[2], st[3], shi[1], slo[1]);
        const bf16_t* Ahi = Ah + ((n & 1) * 2 + 0) * 64 * ALD + c * ALD + q * 8;
        const bf16_t* Alo = Ah + ((n & 1) * 2 + 1) * 64 * ALD + c * ALD + q * 8;
#pragma unroll
        for (int mt = 0; mt < 4; ++mt) {
            f32x4 acc = gb[d][mt];
#pragma unroll
            for (int s = 0; s < 2; ++s) {
                const bf16x8 ahi = *(const bf16x8*)(Ahi + 16 * mt * ALD + 32 * s);
                const bf16x8 alo = *(const bf16x8*)(Alo + 16 * mt * ALD + 32 * s);
                acc = mfma16(ahi, shi[s], acc);
                acc = mfma16(ahi, slo[s], acc);
                acc = mfma16(alo, shi[s], acc);
            }
            st[mt] = acc;
        }
        if (n + 3 < 256) gload(d, n + 3);
        lds_barrier();
    };
    gload(0, 0); gload(1, 1); gload(2, 2);
    __syncthreads();
    lstore(0, 0);
    __syncthreads();
#pragma unroll 1
    for (int n3 = 0; n3 < 255; n3 += 3) { step(0, n3); step(1, n3 + 1); step(2, n3 + 2); }
    step(0, 255);
}
__device__ __forceinline__ void dn3_item(const Params& p, int l, int item, unsigned char* lds) {
    bf16_t* PB = (bf16_t*)(p.ws + OFF_PB);
    const float* DNQ = (const float*)(p.ws + OFF_DNQ) + (size_t)item * 4096;
    const float* DNS = (const float*)(p.ws + OFF_DNS) + (size_t)item * 4096;
    const float* DNO = (const float*)(p.ws + OFF_DNO) + (size_t)item * 4096;
    float* B0 = (float*)lds; float* B1 = B0 + 64 * DLD;
    const int tid = tidx(), ty = tid >> 4, tx = tid & 15;
    const int cchunk = item >> 3, hd = item & 7, t0 = cchunk * 64;
    __syncthreads();
#pragma unroll
    for (int e = 0; e < 4; ++e) {
        const int id = tid + 256 * e, row = id >> 4, c4 = (id & 15) * 4;
        *(f32x4*)(B0 + row * DLD + c4) = *(const f32x4*)(DNQ + row * 64 + c4);
        *(f32x4*)(B1 + row * DLD + c4) = *(const f32x4*)(DNS + row * 64 + c4);
    }
    __syncthreads();
    float acc[4][4];
#pragma unroll
    for (int rr = 0; rr < 4; ++rr) { const f32x4 o = *(const f32x4*)(DNO + (4 * ty + rr) * 64 + 4 * tx); acc[rr][0] = o.x; acc[rr][1] = o.y; acc[rr][2] = o.z; acc[rr][3] = o.w; }
    mm64(B0, B1, acc, ty, tx);
    const f32x4 gn = *(const f32x4*)(p.dn_onorm + l * 64 + 4 * tx);
#pragma unroll
    for (int rr = 0; rr < 4; ++rr) {
        float ss = acc[rr][0] * acc[rr][0] + acc[rr][1] * acc[rr][1] + acc[rr][2] * acc[rr][2] + acc[rr][3] * acc[rr][3];
        ss += __shfl_xor(ss, 1); ss += __shfl_xor(ss, 2); ss += __shfl_xor(ss, 4); ss += __shfl_xor(ss, 8);
        const float rs = rsqrtf(ss * (1.f / 64.f) + EPS);
        const size_t rowoff = (size_t)(t0 + 4 * ty + rr) * PBW + PB_DN + hd * 64 + 4 * tx;
        const u32x2 z = *(const u32x2*)(PB + rowoff + 1536);
        const float o0 = acc[rr][0] * rs * gn.x * siluf(bflo(z.x)), o1 = acc[rr][1] * rs * gn.y * siluf(bfhi(z.x));
        const float o2 = acc[rr][2] * rs * gn.z * siluf(bflo(z.y)), o3 = acc[rr][3] * rs * gn.w * siluf(bfhi(z.y));
        u32x2 w = {pk2(o0, o1), pk2(o2, o3)};
        *(u32x2*)(PB + rowoff) = w;
    }
}

__device__ __forceinline__ void mla_up_tile(const Params& p, int b, int it, unsigned char* lds) {
    const bf16_t* PB = (const bf16_t*)(p.ws + OFF_PB);
    const bf16_t* wb = (const bf16_t*)(p.ws + OFF_WB);
    const int lane = tidx() & 63, wave = tidx() >> 6, wr = wave >> 1, wc = wave & 1, r = lane & 31, h = lane >> 5;
    f32x16 acc[2][4]; ZERO_ACC4(acc);
    if (it < 384) {
        const int pn = it % 3, pm = it / 3;
        gemm_big(PB + (size_t)pm * 128 * PBW + PB_CQ, PBW, wb + W_UQ + (size_t)pn * 256 * 256, 256, acc, lds);
        const float* RQ = (const float*)(p.ws + OFF_RQ);
        const float* rope = (const float*)(p.ws + OFF_ROPE);
        bf16_t* QF = (bf16_t*)(p.ws + OFF_QF);
        const float qsc = 0.10206207261596575f * LOG2E;
#pragma unroll
        for (int mi = 0; mi < 2; ++mi)
#pragma unroll
            for (int reg = 0; reg < 16; ++reg) {
                const int m = pm * 128 + wr * 64 + mi * 32 + (reg & 3) + 8 * (reg >> 2) + 4 * h;
                const float rq = RQ[m] ;
                const float* rp = rope + (size_t)(b * TH + m) * 32;
                const float cs = rp[r & 15], sn = rp[16 + (r & 15)];
#pragma unroll
                for (int ni = 0; ni < 4; ++ni) {
                    const int nb = pn * 256 + wc * 128 + ni * 32, n = nb + r;
                    float v = acc[mi][ni][reg] * rq;
                    if (((nb >> 5) % 3) == 2) {
                        const float o = __builtin_bit_cast(float, __builtin_amdgcn_ds_swizzle(__builtin_bit_cast(int, v), 0x401f));
                        v = (r < 16) ? (v * cs - o * sn) : (v * cs + o * sn);
                    }
                    QF[(size_t)m * 768 + n] = (bf16_t)(pk2(v * qsc, 0.f) & 0xffff);
                }
            }
    } else {
        const int j = it - 384, pn = j & 3, pm = j >> 2;
        gemm_big(PB + (size_t)pm * 128 * PBW + PB_CKV, PBW, wb + W_UKV + (size_t)pn * 256 * 128, 128, acc, lds);
        const float* RKV = (const float*)(p.ws + OFF_RKV);
        bf16_t* KM = (bf16_t*)(p.ws + OFF_KM); bf16_t* VTM = (bf16_t*)(p.ws + OFF_VTM);
        const int head = pn * 2 + wc;
#pragma unroll
        for (int mi = 0; mi < 2; ++mi) {
            const int mb = pm * 128 + wr * 64 + mi * 32 + 4 * h;
            float rs[16];
#pragma unroll
            for (int reg = 0; reg < 16; ++reg) rs[reg] = RKV[mb + (reg & 3) + 8 * (reg >> 2)];
#pragma unroll
            for (int ni = 0; ni < 2; ++ni) {
#pragma unroll
                for (int reg = 0; reg < 16; ++reg)
                    KM[((size_t)(mb + (reg & 3) + 8 * (reg >> 2)) * 8 + head) * 96 + ni * 32 + r] = (bf16_t)(pk2(acc[mi][ni][reg] * rs[reg], 0.f) & 0xffff);
            }
#pragma unroll
            for (int ni = 2; ni < 4; ++ni) {
#pragma unroll
                for (int g = 0; g < 4; ++g) {
                    u32x2 w = {pk2(acc[mi][ni][4 * g] * rs[4 * g], acc[mi][ni][4 * g + 1] * rs[4 * g + 1]), pk2(acc[mi][ni][4 * g + 2] * rs[4 * g + 2], acc[mi][ni][4 * g + 3] * rs[4 * g + 3])};
                    *(u32x2*)(VTM + (size_t)(head * 64 + (ni - 2) * 32 + r) * TH + mb + 8 * g) = w;
                }
            }
        }
    }
}

template <int D>
__device__ __forceinline__ void attn_item(const bf16_t* Q, int qs, const bf16_t* Kp, int kst, const bf16_t* Vt, bf16_t* O, int os, const float* ck, const unsigned* nrm, int qb, unsigned char* lds) {
    constexpr int KLD = D + 8, NKP = D / 32, KPR = D / 8;
    bf16_t* Ks = (bf16_t*)lds; bf16_t* Vs = Ks + 2 * 64 * KLD; float* cks = (float*)(Vs + 2 * 64 * 72);
    const int tid = tidx(), lane = tid & 63, wave = tid >> 6, r = lane & 31, h = lane >> 5;
    const int q0 = qb * 128, qw0 = q0 + 32 * wave;
    bf16x8 qf[D / 16];
#pragma unroll
    for (int ks = 0; ks < D / 16; ++ks) qf[ks] = *(const bf16x8*)(Q + (size_t)(qw0 + r) * qs + ks * 16 + h * 8);
    const int nkt = (q0 + 128) / 64;
    u32x4 rk[2][NKP], rv[2][2]; float rck[2] = {0.f, 0.f};
    float coff = 0.f; bool fx = false;
    if (ck) {
        const float beff = 1.01f * sqrtf(__uint_as_float(nrm[0]) * __uint_as_float(nrm[8])) + 1.f;
        const float cref = ck[q0 + 127];
        fx = (2.f * beff + (ck[q0] - cref)) < 100.f;
        if (fx) coff = cref - beff;
    }
    auto gload = [&](int st, int kt) {
        const int k0 = kt * 64;
#pragma unroll
        for (int i = 0; i < NKP; ++i) { const int id = tid + 256 * i, row = id / KPR, c = id % KPR; rk[st][i] = *(const u32x4*)(Kp + (size_t)(k0 + row) * kst + c * 8); }
#pragma unroll
        for (int i = 0; i < 2; ++i) { const int id = tid + 256 * i, row = id >> 3, c = id & 7; rv[st][i] = *(const u32x4*)(Vt + (size_t)row * TH + k0 + c * 8); }
        if (ck && tid < 64) rck[st] = ck[k0 + tid];
    };
    auto lstore = [&](int st, int buf) {
#pragma unroll
        for (int i = 0; i < NKP; ++i) { const int id = tid + 256 * i, row = id / KPR, c = id % KPR; *(u32x4*)(Ks + buf * 64 * KLD + row * KLD + c * 8) = rk[st][i]; }
#pragma unroll
        for (int i = 0; i < 2; ++i) { const int id = tid + 256 * i, row = id >> 3, c = id & 7; *(u32x4*)(Vs + buf * 64 * 72 + row * 72 + c * 8) = rv[st][i]; }
        if (ck && tid < 64) cks[buf * 64 + tid] = coff - rck[st];
    };
    f32x16 ot[2];
#pragma unroll
    for (int e = 0; e < 16; ++e) { ot[0][e] = 0.f; ot[1][e] = 0.f; }
    float mrun = -INFINITY, lsum = 0.f;
    auto tile = [&](int kt, int cur) {
        const int k0 = kt * 64;
        if (k0 <= qw0 + 31) {
            const bf16_t* Kc = Ks + cur * 64 * KLD + r * KLD + h * 8;
            const float* ckc = cks + cur * 64;
            f32x16 st[2];
            const float moff = (!ck && kt > 0) ? mrun : 0.f;
#pragma unroll
            for (int mt = 0; mt < 2; ++mt)
#pragma unroll
                for (int g = 0; g < 4; ++g) {
                    if (ck) {
                        const f32x4 c4 = *(const f32x4*)(ckc + 32 * mt + 8 * g + 4 * h);
#pragma unroll
                        for (int e = 0; e < 4; ++e) st[mt][4 * g + e] = c4[e];
                    } else {
#pragma unroll
                        for (int e = 0; e < 4; ++e) st[mt][4 * g + e] = -moff;
                    }
                }
            {
                bf16x8 kfr[2][2];
                kfr[0][0] = *(const bf16x8*)(Kc); kfr[0][1] = *(const bf16x8*)(Kc + 32 * KLD);
#pragma unroll
                for (int ks = 0; ks < D / 16; ++ks) {
                    const int cb = ks & 1, nb = cb ^ 1;
                    if (ks + 1 < D / 16) { kfr[nb][0] = *(const bf16x8*)(Kc + (ks + 1) * 16); kfr[nb][1] = *(const bf16x8*)(Kc + 32 * KLD + (ks + 1) * 16); }
                    __builtin_amdgcn_sched_barrier(0);
                    st[0] = mfma32(kfr[cb][0], qf[ks], st[0]); st[1] = mfma32(kfr[cb][1], qf[ks], st[1]);
                    __builtin_amdgcn_sched_barrier(0);
                }
            }
            if (k0 + 63 > qw0) {
#pragma unroll
                for (int mt = 0; mt < 2; ++mt)
#pragma unroll
                    for (int e = 0; e < 16; ++e) {
                        const int key = 32 * mt + (e & 3) + 8 * (e >> 2) + 4 * h;
                        if (k0 + key > qw0 + r) st[mt][e] = -INFINITY;
                    }
            }
            float sub = 0.f; bool needsub = false;
            if (!(ck && fx)) {
                float mloc = -INFINITY;
#pragma unroll
                for (int e = 0; e < 16; ++e) mloc = max3f(mloc, st[0][e], st[1][e]);
                { float a, c; halves32(mloc, a, c); mloc = fmaxf(a, c); }
                float alpha;
                if (ck) {
                    const float mnew = fmaxf(mrun, mloc);
                    alpha = ex2(mrun - mnew);
                    mrun = mnew; sub = mnew; needsub = true;
                } else {
                    const float d = (kt == 0) ? mloc : fmaxf(mloc, 0.f);
                    alpha = (kt == 0) ? 0.f : ex2(-d);
                    mrun = moff + d;
                    if (__builtin_amdgcn_ballot_w64(d != 0.f) != 0ull) { sub = d; needsub = true; }
                }
                lsum *= alpha;
                if (__builtin_amdgcn_ballot_w64(alpha != 1.f) != 0ull) {
#pragma unroll
                    for (int e = 0; e < 16; ++e) { ot[0][e] *= alpha; ot[1][e] *= alpha; }
                }
            }
            const bf16_t* Vc = Vs + cur * 64 * 72 + r * 72 + 4 * h;
            if (needsub) {
#pragma unroll
                for (int e = 0; e < 16; ++e) { st[0][e] -= sub; st[1][e] -= sub; }
            }
            {
                u32x2 vfr[2][2][2];
                float psum = 0.f;
#pragma unroll
                for (int dt = 0; dt < 2; ++dt) { vfr[0][dt][0] = *(const u32x2*)(Vc + dt * 32 * 72); vfr[0][dt][1] = *(const u32x2*)(Vc + dt * 32 * 72 + 8); }
#pragma unroll
                for (int stp = 0; stp < 4; ++stp) {
                    const int mt = stp >> 1, s2 = stp & 1, cb = stp & 1, nb = cb ^ 1;
                    if (stp < 3) {
                        const int mtn = (stp + 1) >> 1, s2n = (stp + 1) & 1;
#pragma unroll
                        for (int dt = 0; dt < 2; ++dt) {
                            vfr[nb][dt][0] = *(const u32x2*)(Vc + dt * 32 * 72 + 32 * mtn + 16 * s2n);
                            vfr[nb][dt][1] = *(const u32x2*)(Vc + dt * 32 * 72 + 32 * mtn + 16 * s2n + 8);
                        }
                    }
                    float pe[8];
#pragma unroll
                    for (int e = 0; e < 8; ++e) pe[e] = ex2(st[mt][8 * s2 + e]);
                    psum += ((pe[0] + pe[1]) + (pe[2] + pe[3])) + ((pe[4] + pe[5]) + (pe[6] + pe[7]));
                    const bf16x8 pf = mk8(pk2(pe[0], pe[1]), pk2(pe[2], pe[3]), pk2(pe[4], pe[5]), pk2(pe[6], pe[7]));
                    __builtin_amdgcn_sched_barrier(0);
#pragma unroll
                    for (int dt = 0; dt < 2; ++dt)
                        ot[dt] = mfma32(mk8(vfr[cb][dt][0].x, vfr[cb][dt][0].y, vfr[cb][dt][1].x, vfr[cb][dt][1].y), pf, ot[dt]);
                    __builtin_amdgcn_sched_barrier(0);
                }
                lsum += psum;
            }
        }
        if (kt + 1 < nkt) {
            lstore(cur ^ 1, cur ^ 1);
            if (kt + 3 < nkt) gload(cur ^ 1, kt + 3);
        }
        lds_barrier();
    };
    int kts = 0;
    if (ck) {
        int* s4 = (int*)(lds + LDS_BYTES - 64);
        const float bnd = sqrtf(__uint_as_float(nrm[0]) * __uint_as_float(nrm[8]));
        const float thr = -(162.f + 2.02f * bnd);
        bool keep = true;
        if (tid < nkt) keep = (ck[q0] - ck[64 * tid + 63]) >= thr;
        const unsigned long long bal = __builtin_amdgcn_ballot_w64(keep);
        if (lane == 0) s4[wave] = 64 * wave + (bal ? (int)__builtin_ctzll(bal) : 64);
    }
    __syncthreads();
    if (ck) {
        const int* s4 = (const int*)(lds + LDS_BYTES - 64);
        kts = min(min(s4[0], s4[1]), min(s4[2], s4[3]));
        kts = min(kts, nkt - 2) & ~1;
    }
    gload(0, kts);
    gload(1, kts + 1);
    lstore(0, 0);
    if (kts + 2 < nkt) gload(0, kts + 2);
    lds_barrier();
#pragma unroll 1
    for (int kt = kts; kt < nkt; kt += 2) { tile(kt, 0); tile(kt + 1, 1); }
    const float l = lsum + __shfl_xor(lsum, 32);
    const float inv = 1.f / l;
#pragma unroll
    for (int dt = 0; dt < 2; ++dt)
#pragma unroll
        for (int g = 0; g < 4; ++g) {
            u32x2 w = {pk2(ot[dt][4 * g] * inv, ot[dt][4 * g + 1] * inv), pk2(ot[dt][4 * g + 2] * inv, ot[dt][4 * g + 3] * inv)};
            *(u32x2*)(O + (size_t)(qw0 + r) * os + 32 * dt + 8 * g + 4 * h) = w;
        }
}

__device__ __forceinline__ void phase_attn(const Params& p, int l, int b, unsigned char* lds, int dup) {
    int* ctr = (int*)(p.ws + OFF_CTRL) + 32 + (l * 2 + b) * 8 + (dup ? 64 : 0);
    bf16_t* dry = (bf16_t*)(p.ws + WS_END);
    int* s_item = (int*)(lds + LDS_BYTES - 16);
    bf16_t* PB = (bf16_t*)(p.ws + OFF_PB);
    const int myq = (int)(xb_xcc_id() & 7u);
    unsigned* dn2flag = (unsigned*)(p.ws + OFF_CTRL) + 16 + (l * 2 + b);
    bool dn2_seen = false;
    if (!dup && blockIdx.x < 8) {
        dn2_block(p, blockIdx.x, lds);
        asm volatile("s_waitcnt vmcnt(0)" ::: "memory");
        __syncthreads();
        if (threadIdx.x == 0) {
            __builtin_amdgcn_fence(__ATOMIC_RELEASE, "agent");
            asm volatile("s_waitcnt vmcnt(0)" ::: "memory");
            (void)xb_add(dn2flag, 1u);
        }
    }
    for (;;) {
        __syncthreads();
        if (tidx() == 0) {
            int found = -1;
            for (int sq = 0; sq < 8; ++sq) {
                const int q = (myq + sq) & 7;
                const int it = atomicAdd(&ctr[q], 1);
                if (it < 512) { found = q * 512 + it; break; }
            }
            *s_item = found;
        }
        __syncthreads();
        const int enc = *s_item;
        if (enc < 0) break;
        const int hd = enc >> 9, it = enc & 511;
        if (it >= 256 && !dup && !dn2_seen) {
            if (threadIdx.x == 0) {
                while (xb_ld(dn2flag) < 8u) __builtin_amdgcn_s_sleep(8);
                __builtin_amdgcn_fence(__ATOMIC_ACQUIRE, "agent");
                asm volatile("s_waitcnt vmcnt(0)" ::: "memory");
            }
            __syncthreads();
            dn2_seen = true;
        }
        if (it < 256) {
            const int qb = 127 - (it >> 1), kind = it & 1;
            if (kind == 0) {
                attn_item<64>(PB + hd * 64, PBW, PB + 512 + hd * 64, PBW, (const bf16_t*)(p.ws + OFF_VTF) + (size_t)hd * 64 * TH,
                              dup ? dry + hd * 64 : PB + hd * 64, dup ? 1024 : PBW, (const float*)(p.ws + OFF_CF) + (size_t)hd * TH,
                              (const unsigned*)(p.ws + OFF_CTRL) + 160 + (l * 2 + b) * 16 + hd, qb, lds);
            } else {
                bf16_t* QF = (bf16_t*)(p.ws + OFF_QF);
                attn_item<96>(QF + hd * 96, 768, (const bf16_t*)(p.ws + OFF_KM) + hd * 96, 768, (const bf16_t*)(p.ws + OFF_VTM) + (size_t)hd * 64 * TH,
                              dup ? dry + 512 + hd * 64 : QF + hd * 96, dup ? 1024 : 768, nullptr, nullptr, qb, lds);
            }
        } else {
            if (!dup) dn3_item(p, l, (it - 256) * 8 + hd, lds);
        }
    }
}

__device__ __forceinline__ void phase_gate(const Params& p, int l, int b, unsigned char* lds) {
    const bf16_t* hb = (const bf16_t*)(p.ws + OFF_HB) + (size_t)b * TH * DM;
    const bf16_t* wg = (const bf16_t*)(p.ws + OFF_WB) + W_G;
    bf16_t* G = (bf16_t*)(p.ws + OFF_G);
    const float* bg = p.b_gate + (size_t)l * 3072;
    const int lane = tidx() & 63, wave = tidx() >> 6, wr = wave >> 1, wc = wave & 1, r = lane & 31, h = lane >> 5;
    int pm, pn;
#pragma unroll 1
    for (int k = 0; tile_at(k, TH / 128, 12, pm, pn); ++k) {
        f32x16 acc[2][4]; ZERO_ACC4(acc);
        gemm_big(hb + (size_t)pm * 128 * DM, DM, wg + (size_t)pn * 256 * DM, DM, acc, lds);
#pragma unroll
        for (int ni = 0; ni < 4; ++ni) {
            const int n = pn * 256 + wc * 128 + ni * 32 + r;
            const float bias = bg[n];
#pragma unroll
            for (int mi = 0; mi < 2; ++mi)
#pragma unroll
                for (int reg = 0; reg < 16; ++reg) {
                    const int m = pm * 128 + wr * 64 + mi * 32 + (reg & 3) + 8 * (reg >> 2) + 4 * h;
                    G[(size_t)m * 3072 + n] = (bf16_t)(pk2(sigmf(acc[mi][ni][reg] + bias), 0.f) & 0xffff);
                }
        }
    }
}
__device__ __forceinline__ void phase_mix(const Params& p, int l, int b, unsigned char* lds) {
    const bf16_t* wb = (const bf16_t*)(p.ws + OFF_WB);
    const bf16_t* PB = (const bf16_t*)(p.ws + OFF_PB);
    const bf16_t* QF = (const bf16_t*)(p.ws + OFF_QF);
    const bf16_t* G = (const bf16_t*)(p.ws + OFF_G);
    bf16_t* MIX = (bf16_t*)(p.ws + OFF_MIX);
    const int lane = tidx() & 63, wave = tidx() >> 6, wr = wave >> 1, wc = wave & 1, r = lane & 31, h = lane >> 5;
    int pm, pn;
#pragma unroll 1
    for (int k = 0; tile_at(k, TH / 128, 8, pm, pn); ++k) {
        f32x16 mix[2][2]; ZERO_ACC(mix);
#pragma unroll 1
        for (int br = 0; br < 3; ++br) {
            f32x16 acc[2][2]; ZERO_ACC(acc);
            const bf16_t* A; long lda; int acs; const bf16_t* W;
            if (br == 0) { A = PB + (size_t)pm * 128 * PBW; lda = PBW; acs = 64; W = wb + W_BRF; }
            else if (br == 1) { A = QF + (size_t)pm * 128 * 768; lda = 768; acs = 96; W = wb + W_BRM; }
            else { A = PB + (size_t)pm * 128 * PBW + PB_DN; lda = PBW; acs = 64; W = wb + W_BRD; }
            gemm_core<2>(A, lda, acs, W + (size_t)pn * 128 * 512, 512, acc, lds);
#pragma unroll
            for (int mi = 0; mi < 2; ++mi)
#pragma unroll
                for (int ni = 0; ni < 2; ++ni) {
                    const bf16_t* gp = G + (size_t)(pm * 128 + wr * 64 + mi * 32 + 4 * h) * 3072 + br * 1024 + pn * 128 + wc * 64 + ni * 32 + r;
#pragma unroll
                    for (int reg = 0; reg < 16; ++reg) {
                        const float g = bflo((uint32_t)gp[(size_t)((reg & 3) + 8 * (reg >> 2)) * 3072]);
                        mix[mi][ni][reg] += g * acc[mi][ni][reg];
                    }
                }
        }
#pragma unroll
        for (int mi = 0; mi < 2; ++mi)
#pragma unroll
            for (int ni = 0; ni < 2; ++ni)
#pragma unroll
                for (int reg = 0; reg < 16; ++reg) {
                    const int m = pm * 128 + wr * 64 + mi * 32 + (reg & 3) + 8 * (reg >> 2) + 4 * h;
                    const int n = pn * 128 + wc * 64 + ni * 32 + r;
                    MIX[(size_t)m * DM + n] = (bf16_t)(pk2(mix[mi][ni][reg], 0.f) & 0xffff);
                }
    }
}

__device__ __forceinline__ void phase_prologue(const Params& p) {
    const size_t gt = (size_t)blockIdx.x * 256 + tidx(), gs = (size_t)gridDim.x * 256;
    const f32x4* xs = (const f32x4*)p.x; f32x4* xo = (f32x4*)p.out;
    for (size_t i = gt; i < (size_t)TOK * DM / 4; i += gs) xo[i] = xs[i];
    float* rope = (float*)(p.ws + OFF_ROPE);
    for (size_t i = gt; i < (size_t)TOK * 16; i += gs) {
        const int t = (int)(i >> 4), j = (int)(i & 15);
        const float inv = ex2(-(float)j * 0.8304820237218406f);
        const float ang = (float)p.pos[t] * inv;
        const double a = (double)ang;
        const double kk = __builtin_rint(a * 0.15915494309189535);
        const float rr = (float)__builtin_fma(-kk, 6.283185307179586, a);
        rope[(size_t)t * 32 + j] = __cosf(rr);
        rope[(size_t)t * 32 + 16 + j] = __sinf(rr);
    }
    if (blockIdx.x == 0 && tidx() < 64) ((int*)(p.ws + OFF_CTRL))[tidx()] = 0;
}

enum { K_PRO = 0, K_FINAL, K_S0, K_GU1, K_DOWN1, K_NORMMIX, K_WIN, K_MID, K_UP, K_ATTN, K_GATE, K_MIX, K_WOUT, K_NORM2, K_GU2, K_DOWN2, K_COUNT };
__host__ __device__ __forceinline__ int kind_of(int ph, int& l, int& b) {
    l = 0; b = 0;
    if (ph == 0) return K_PRO;
    if (ph == NPHASE - 1) return K_FINAL;
    l = (ph - 1) / 21; const int sp = (ph - 1) % 21;
    if (sp == 0) return K_S0;
    if (sp == 1) return K_GU1;
    if (sp == 2) return K_DOWN1;
    if (sp == 3) return K_NORMMIX;
    if (sp == 18) return K_NORM2;
    if (sp == 19) return K_GU2;
    if (sp == 20) return K_DOWN2;
    b = (sp - 4) / 7;
    return K_WIN + (sp - 4) % 7;
}
template <int KIND>
__device__ __forceinline__ void run_kind(const Params& p0, int l, int b, unsigned char* lds, int dup = 0) {
    Params p = p0;
    size_t zoff = 0;
    asm volatile("" : "+s"(zoff));
    p.ws = p0.ws + zoff; p.out = p0.out + zoff;
    const bf16_t* wb = (const bf16_t*)(p.ws + OFF_WB);
    bf16_t* hb = (bf16_t*)(p.ws + OFF_HB);
    const bf16_t* act = (const bf16_t*)(p.ws + OFF_BIG);
    if constexpr (KIND == K_PRO) { phase_prologue(p); }
    else if constexpr (KIND == K_FINAL) { phase_rmsnorm(p.out, p.final_norm, nullptr, p.out); }
    else if constexpr (KIND == K_S0) { phase_wconv(p, l, lds); phase_rmsnorm(p.out, p.ffn1_norm + l * DM, hb, nullptr); }
    else if constexpr (KIND == K_GU1) { phase_gu(p, wb + W_GU1, lds); }
    else if constexpr (KIND == K_DOWN1) { phase_resid(p, act, DFF, TOK, wb + W_DN1, DFF, p.out, dup ? 0.f : 0.5f, lds); }
    else if constexpr (KIND == K_NORMMIX) { phase_rmsnorm(p.out, p.mix_norm + l * DM, hb, nullptr); }
    else if constexpr (KIND == K_NORM2) { phase_rmsnorm(p.out, p.ffn2_norm + l * DM, hb, nullptr); }
    else if constexpr (KIND == K_GU2) { phase_gu(p, wb + W_GU2, lds); }
    else if constexpr (KIND == K_DOWN2) { phase_resid(p, act, DFF, TOK, wb + W_DN2, DFF, p.out, dup ? 0.f : 0.5f, lds); }
    else if constexpr (KIND == K_WIN) { phase_win(p, b, lds); }
    else if constexpr (KIND == K_MID) {
        constexpr int NI = 8 + 256 + 2048;
        int* qctr = (int*)(p.ws + OFF_CTRL) + 448 + (l * 2 + b) + (dup ? 8 : 0);
        int* s_it = (int*)(lds + LDS_BYTES - 16);
        for (;;) {
            __syncthreads();
            if (tidx() == 0) *s_it = atomicAdd(qctr, 1);
            __syncthreads();
            const int it = *s_it;
            if (it >= NI) break;
            if (it < 8) fox_cumsum_item(p, l, it, lds);
            else if (it < 8 + 256) mla_rows_item(p, b, it - 8, (unsigned*)(p.ws + OFF_CTRL) + 160 + (l * 2 + b) * 16);
            else dn1_item(p, l, it - 8 - 256, lds);
        }
    }
    else if constexpr (KIND == K_UP) {
#pragma unroll 1
        for (int it = blockIdx.x; it < 384 + 512; it += gridDim.x) mla_up_tile(p, b, it, lds);
    }
    else if constexpr (KIND == K_ATTN) { phase_attn(p, l, b, lds, dup); }
    else if constexpr (KIND == K_GATE) { phase_gate(p, l, b, lds); }
    else if constexpr (KIND == K_MIX) { phase_mix(p, l, b, lds); }
    else if constexpr (KIND == K_WOUT) { phase_resid(p, (const bf16_t*)(p.ws + OFF_MIX), DM, TH, wb + W_OUT, DM, p.out + (size_t)b * TH * DM, dup ? 0.f : 1.0f, lds); }
}

template <int KIND>
__global__ void __launch_bounds__(256, 2) phase_k(Params p, int l, int b) {
    extern __shared__ __attribute__((aligned(16))) unsigned char lds[];
    run_kind<KIND>(p, l, b, lds);
}

__device__ __forceinline__ void run_any(const Params& p, int kind, int l, int b, unsigned char* lds, int dup) {
    switch (kind) {
    case K_PRO: run_kind<K_PRO>(p, l, b, lds, dup); break;
    case K_FINAL: run_kind<K_FINAL>(p, l, b, lds, dup); break;
    case K_S0: run_kind<K_S0>(p, l, b, lds, dup); break;
    case K_GU1: run_kind<K_GU1>(p, l, b, lds, dup); break;
    case K_DOWN1: run_kind<K_DOWN1>(p, l, b, lds, dup); break;
    case K_NORMMIX: run_kind<K_NORMMIX>(p, l, b, lds, dup); break;
    case K_WIN: run_kind<K_WIN>(p, l, b, lds, dup); break;
    case K_MID: run_kind<K_MID>(p, l, b, lds, dup); break;
    case K_UP: run_kind<K_UP>(p, l, b, lds, dup); break;
    case K_ATTN: run_kind<K_ATTN>(p, l, b, lds, dup); break;
    case K_GATE: run_kind<K_GATE>(p, l, b, lds, dup); break;
    case K_MIX: run_kind<K_MIX>(p, l, b, lds, dup); break;
    case K_WOUT: run_kind<K_WOUT>(p, l, b, lds, dup); break;
    case K_NORM2: run_kind<K_NORM2>(p, l, b, lds, dup); break;
    case K_GU2: run_kind<K_GU2>(p, l, b, lds, dup); break;
    default: run_kind<K_DOWN2>(p, l, b, lds, dup); break;
    }
}
#if ONE_LAUNCH
__global__ void __launch_bounds__(256, 2) mega(Params p, int ph_lo, int ph_hi) {
    extern __shared__ __attribute__((aligned(16))) unsigned char lds[];
    volatile LAS unsigned* xst = (volatile LAS unsigned*)(lds + LDS_BYTES - 32);
    if (threadIdx.x == 0) { xst[0] = 0u; xst[1] = 0u; }
    __syncthreads();
    const XcdBarrier xb = xcd_barrier_post((unsigned*)(p.ws + OFF_CTRL) + 1024, xst);
    for (int ph = ph_lo; ph < ph_hi; ++ph) {
        int l, b; const int kind = kind_of(ph, l, b);
#if PROBE_DUP
        {
            int cat = 32;
            if (kind == K_GU1 || kind == K_DOWN1 || kind == K_GU2 || kind == K_DOWN2) cat = 1;
            else if (kind == K_WIN || kind == K_GATE || kind == K_MIX || kind == K_WOUT) cat = 2;
            else if (kind == K_ATTN) cat = 4;
            else if (kind == K_MID) cat = 8;
            else if (kind == K_UP) cat = 16;
            else if (kind == K_FINAL) cat = 0;
            if (cat & PROBE_DUP) { run_any(p, kind, l, b, lds, 1); xcd_barrier(xb); }
        }
#endif
        run_any(p, kind, l, b, lds, 0);
        if (ph + 1 < ph_hi) {
            if (ph == ph_lo) cg::this_grid().sync();
            else xcd_barrier(xb);
#if (PROBE_DUP & 64)
            xcd_barrier(xb);
#endif
        }
    }
}
#endif

template <int KIND>
static void launch_kind(const Params& p, int l, int b, int grid, hipStream_t stream) {
    static bool attr = false;
    if (!attr) { (void)hipFuncSetAttribute((const void*)phase_k<KIND>, hipFuncAttributeMaxDynamicSharedMemorySize, LDS_BYTES); attr = true; }
    hipLaunchKernelGGL(phase_k<KIND>, dim3(grid), dim3(256), LDS_BYTES, stream, p, l, b);
}

extern "C" void kernel_launch(void* const* d_in, const int* in_sizes, int n_in, void* d_out, int out_size, void* d_ws, size_t ws_size, hipStream_t stream) {
    static int grid = 0;
    if (grid == 0) {
        if (ws_size < WS_END) { fprintf(stderr, "kernel_launch: workspace too small: %zu < %zu\n", ws_size, (size_t)WS_END); grid = -1; return; }
        int dev = 0, cus = 0, per_cu = 0;
        (void)hipGetDevice(&dev);
        (void)hipDeviceGetAttribute(&cus, hipDeviceAttributeMultiprocessorCount, dev);
#if ONE_LAUNCH
        (void)hipFuncSetAttribute((const void*)mega, hipFuncAttributeMaxDynamicSharedMemorySize, LDS_BYTES);
        (void)hipOccupancyMaxActiveBlocksPerMultiprocessor(&per_cu, (const void*)mega, 256, LDS_BYTES);
#else
        per_cu = 2;
#endif
        if (per_cu < 1) per_cu = 1;
        if (per_cu > 2) per_cu = 2;
        grid = cus * per_cu;
        (void)hipGetLastError();
    }
    if (grid < 0) return;
    Params p{};
    p.x = (const float*)d_in[0]; p.pos = (const int*)d_in[1];
    p.ffn1_norm = (const float*)d_in[2]; p.ffn1_gu = (const float*)d_in[3]; p.ffn1_down = (const float*)d_in[4];
    p.mix_norm = (const float*)d_in[5]; p.w_in = (const float*)d_in[6]; p.b_gate = (const float*)d_in[7]; p.fox_bf = (const float*)d_in[8];
    p.mla_qn = (const float*)d_in[9]; p.mla_uq = (const float*)d_in[10]; p.mla_kvn = (const float*)d_in[11]; p.mla_ukv = (const float*)d_in[12];
    p.dn_conv = (const float*)d_in[13]; p.dn_alog = (const float*)d_in[14]; p.dn_dtb = (const float*)d_in[15]; p.dn_onorm = (const float*)d_in[16];
    p.br_fox = (const float*)d_in[17]; p.br_mla = (const float*)d_in[18]; p.br_dn = (const float*)d_in[19]; p.w_out = (const float*)d_in[20];
    p.ffn2_norm = (const float*)d_in[21]; p.ffn2_gu = (const float*)d_in[22]; p.ffn2_down = (const float*)d_in[23]; p.final_norm = (const float*)d_in[24];
    p.out = (float*)d_out; p.ws = (unsigned char*)d_ws;
#if ONE_LAUNCH
    (void)hipMemsetAsync((unsigned char*)d_ws + OFF_CTRL, 0, 32768, stream);
    int lo = 0, hi = NPHASE;
    void* args[] = {&p, &lo, &hi};
    hipError_t e = hipLaunchCooperativeKernel((const void*)mega, dim3(grid), dim3(256), args, LDS_BYTES, stream);
    if (e != hipSuccess) fprintf(stderr, "cooperative launch failed: %s (grid %d)\n", hipGetErrorString(e), grid);
#else
    for (int ph = 0; ph < NPHASE; ++ph) {
        int l, b; const int kind = kind_of(ph, l, b);
        switch (kind) {
        case K_PRO: launch_kind<K_PRO>(p, l, b, grid, stream); break;
        case K_FINAL: launch_kind<K_FINAL>(p, l, b, grid, stream); break;
        case K_S0: launch_kind<K_S0>(p, l, b, grid, stream); break;
        case K_GU1: launch_kind<K_GU1>(p, l, b, grid, stream); break;
        case K_DOWN1: launch_kind<K_DOWN1>(p, l, b, grid, stream); break;
        case K_NORMMIX: launch_kind<K_NORMMIX>(p, l, b, grid, stream); break;
        case K_WIN: launch_kind<K_WIN>(p, l, b, grid, stream); break;
        case K_MID: launch_kind<K_MID>(p, l, b, grid, stream); break;
        case K_UP: launch_kind<K_UP>(p, l, b, grid, stream); break;
        case K_ATTN: launch_kind<K_ATTN>(p, l, b, grid, stream); break;
        case K_GATE: launch_kind<K_GATE>(p, l, b, grid, stream); break;
        case K_MIX: launch_kind<K_MIX>(p, l, b, grid, stream); break;
        case K_WOUT: launch_kind<K_WOUT>(p, l, b, grid, stream); break;
        case K_NORM2: launch_kind<K_NORM2>(p, l, b, grid, stream); break;
        case K_GU2: launch_kind<K_GU2>(p, l, b, grid, stream); break;
        default: launch_kind<K_DOWN2>(p, l, b, grid, stream); break;
        }
    }
#endif
}
```
